# Optimizing an MI355X kernel written in HIP

```python
import jax, jax.numpy as jnp
from jax import lax
import numpy as np

D_MODEL = 1024
BATCH = 8
SEQ = 2048
DEPTH = 4
DEC_BATCH = 128
DEC_SEQ = 1
PAST_LEN = 16384
PAGE_SIZE = 128

N_MEM = 256
HEAD_DIM = 64
POOL_WIDTH = D_MODEL // 4
POOL_WINDOWS = (2, 4, 8, 16)
POOL_GROUP = POOL_WIDTH // len(POOL_WINDOWS)
POOL_BUF = max(POOL_WINDOWS) - 1
RWKV_WIDTH = D_MODEL // 2
RWKV_HEADS = RWKV_WIDTH // HEAD_DIM
XA_WIDTH = D_MODEL // 4
XA_HEADS = 4
XA_HEAD_DIM = XA_WIDTH // XA_HEADS
MIX_WIDTH = POOL_WIDTH + RWKV_WIDTH + XA_WIDTH
DECAY_LORA = 64
ICLR_LORA = 64
SHIFT_WIDTH = 3 * RWKV_WIDTH + DECAY_LORA + ICLR_LORA
IN_WIDTH = 2 * POOL_WIDTH + SHIFT_WIDTH + RWKV_WIDTH + 2 * XA_WIDTH
IN_SPLITS = [POOL_WIDTH, 2 * POOL_WIDTH, 2 * POOL_WIDTH + SHIFT_WIDTH,
             2 * POOL_WIDTH + SHIFT_WIDTH + RWKV_WIDTH,
             2 * POOL_WIDTH + SHIFT_WIDTH + RWKV_WIDTH + XA_WIDTH]
EPS = 1e-6
GN_EPS = HEAD_DIM * 1e-5

kernel_name = 'pool_rwkv7_memxattn_hybrid_step'

F32 = jnp.float32


def _rms_norm(x, g):
    xf = x.astype(F32)
    y = xf * lax.rsqrt(jnp.mean(xf * xf, axis=-1, keepdims=True) + EPS)
    return (y * g.astype(F32)).astype(x.dtype)


def _pool_mix(v, buf, start_pos, pool_w, pool_scale):
    B, T, _ = v.shape
    full = jnp.concatenate([buf, v], axis=1).astype(F32)
    csum = jnp.concatenate([jnp.zeros((B, 1, POOL_WIDTH), F32), jnp.cumsum(full, axis=1)], axis=1)
    pos = start_pos + jnp.arange(T)
    cur = full[:, POOL_BUF:]
    hi = csum[:, POOL_BUF + 1:POOL_BUF + 1 + T]
    groups = []
    for gi, win in enumerate(POOL_WINDOWS):
        sl = slice(gi * POOL_GROUP, (gi + 1) * POOL_GROUP)
        lo = csum[:, POOL_BUF + 1 - win:POOL_BUF + 1 - win + T, sl]
        cnt = jnp.minimum(pos + 1, win).astype(F32)[None, :, None]
        groups.append((hi[..., sl] - lo) / cnt - cur[..., sl])
    pooled = jnp.stack(groups, axis=2)
    y = jnp.einsum('btng,nge->btne', pooled, pool_w.astype(F32)).reshape(B, T, POOL_WIDTH)
    return (y * pool_scale.astype(F32)).astype(v.dtype)


def _rwkv7(xs, S0, w0, w_w2, a0, w_a2, k_k, k_a, r_k, ln_g, ln_b):
    B, T, _ = xs.shape
    H, N, R = RWKV_HEADS, HEAD_DIM, RWKV_WIDTH
    xs = xs.astype(F32)
    r = xs[..., :R]
    k = xs[..., R:2 * R]
    v = xs[..., 2 * R:3 * R]
    wd = xs[..., 3 * R:3 * R + DECAY_LORA]
    ad = xs[..., 3 * R + DECAY_LORA:]
    w = -jax.nn.softplus(-(w0.astype(F32) + jnp.tanh(wd) @ w_w2.astype(F32))) - 0.5
    decay = jnp.exp(-jnp.exp(w))
    a = jax.nn.sigmoid(a0.astype(F32) + ad @ w_a2.astype(F32))
    heads = lambda t: t.reshape(B, T, H, N)
    kk = heads(k * k_k.astype(F32))
    kk = kk / jnp.maximum(jnp.sqrt(jnp.sum(kk * kk, axis=-1, keepdims=True)), 1e-12)
    k = k * (1.0 + (a - 1.0) * k_a.astype(F32))
    r, k, v, decay, a = heads(r), heads(k), heads(v), heads(decay), heads(a)

    def step(S, inp):
        r_t, w_t, k_t, v_t, kk_t, a_t = inp
        s_kk = jnp.einsum('bhij,bhj->bhi', S, kk_t)
        S = (S * w_t[:, :, None, :] - s_kk[..., None] * (kk_t * a_t)[:, :, None, :]
             + v_t[..., None] * k_t[:, :, None, :])
        return S, jnp.einsum('bhij,bhj->bhi', S, r_t)

    tm = lambda t: jnp.swapaxes(t, 0, 1)
    S_T, y = lax.scan(step, S0.astype(F32), (tm(r), tm(decay), tm(k), tm(v), tm(kk), tm(a)))
    y = tm(y)
    mu = jnp.mean(y, axis=-1, keepdims=True)
    var = jnp.mean(jnp.square(y - mu), axis=-1, keepdims=True)
    y = (y - mu) * lax.rsqrt(var + GN_EPS) * ln_g.astype(F32).reshape(H, N) + ln_b.astype(F32).reshape(H, N)
    y = y + jnp.sum(r * k * r_k.astype(F32), axis=-1, keepdims=True) * v
    return y.reshape(B, T, R), S_T


def _mem_kv(mem, g, w_kv):
    B = mem.shape[0]
    kv = _rms_norm(mem, g) @ w_kv
    k = kv[..., :XA_WIDTH].reshape(B, N_MEM, XA_HEADS, XA_HEAD_DIM)
    v = kv[..., XA_WIDTH:].reshape(B, N_MEM, XA_HEADS, XA_HEAD_DIM)
    return k, v


def _cross_attend(q, mk, mv):
    B, T, _ = q.shape
    qh = q.reshape(B, T, XA_HEADS, XA_HEAD_DIM).astype(F32)
    s = jnp.einsum('bthd,bmhd->bhtm', qh, mk.astype(F32)) * (XA_HEAD_DIM ** -0.5)
    p = jax.nn.softmax(s, axis=-1)
    o = jnp.einsum('bhtm,bmhd->bthd', p, mv.astype(F32))
    return o.reshape(B, T, XA_WIDTH).astype(q.dtype)


def _trunk(x, start_pos, pool_buf, shift_prev, wkv, mem_k, mem_v, p):
    new_pool, new_shift, new_wkv = [], [], []
    for l in range(DEPTH):
        xn = _rms_norm(x, p['norm_g'][l])
        h = xn @ p['w_in'][l]
        pool_v, pool_g, rw, rw_g, q, xa_g = jnp.split(h, IN_SPLITS, axis=-1)
        pool_y = _pool_mix(pool_v, pool_buf[l], start_pos, p['pool_w'][l], p['pool_scale'][l]) * jax.nn.silu(pool_g)
        new_pool.append(jnp.concatenate([pool_buf[l].astype(pool_v.dtype), pool_v], axis=1)[:, -POOL_BUF:])
        prev = jnp.concatenate([shift_prev[l][:, None].astype(rw.dtype), rw[:, :-1]], axis=1)
        rws = rw + (prev - rw) * p['shift_mu'][l]
        new_shift.append(rw[:, -1])
        rwkv_y, S_T = _rwkv7(rws, wkv[l], p['w0'][l], p['w_w2'][l], p['a0'][l], p['w_a2'][l],
                             p['k_k'][l], p['k_a'][l], p['r_k'][l], p['ln_x_g'][l], p['ln_x_b'][l])
        new_wkv.append(S_T.astype(x.dtype))
        rwkv_y = rwkv_y.astype(x.dtype) * jax.nn.silu(rw_g)
        xa_y = _cross_attend(q, mem_k[l], mem_v[l]) * jax.nn.silu(xa_g)
        mixed = jnp.concatenate([pool_y, rwkv_y, xa_y], axis=-1)
        x = x + mixed @ p['w_out'][l]
    y = _rms_norm(x, p['final_norm_g'])
    return y, jnp.stack(new_pool), jnp.stack(new_shift), jnp.stack(new_wkv)


def setup_inputs(seed: int = 0) -> dict:
    key = jax.random.key(seed)
    ks = jax.random.split(key, 32)
    nrm = lambda k, shape, s: jax.random.normal(k, shape, F32) * s
    L = DEPTH
    return {
        'x_prompt': nrm(ks[0], (BATCH, SEQ, D_MODEL), 1.0),
        'x_sample': nrm(ks[1], (DEC_BATCH, DEC_SEQ, D_MODEL), 1.0),
        'mem_prompt': nrm(ks[2], (BATCH, N_MEM, D_MODEL), 1.0),
        'state_pool': nrm(ks[3], (L, DEC_BATCH, POOL_BUF, POOL_WIDTH), 1.0),
        'state_shift': nrm(ks[4], (L, DEC_BATCH, SHIFT_WIDTH), 1.0),
        'state_wkv': nrm(ks[5], (L, DEC_BATCH, RWKV_HEADS, HEAD_DIM, HEAD_DIM), 0.5),
        'cache_mem_k': nrm(ks[6], (L, DEC_BATCH, N_MEM, XA_HEADS, XA_HEAD_DIM), 1.0),
        'cache_mem_v': nrm(ks[7], (L, DEC_BATCH, N_MEM, XA_HEADS, XA_HEAD_DIM), 1.0),
        'norm_g': 1.0 + nrm(ks[8], (L, D_MODEL), 0.05),
        'w_in': nrm(ks[9], (L, D_MODEL, IN_WIDTH), D_MODEL ** -0.5),
        'w_out': nrm(ks[10], (L, MIX_WIDTH, D_MODEL), 0.5 * MIX_WIDTH ** -0.5),
        'pool_w': nrm(ks[11], (L, len(POOL_WINDOWS), POOL_GROUP, POOL_GROUP), POOL_GROUP ** -0.5),
        'pool_scale': 1.0 + nrm(ks[12], (L, POOL_WIDTH), 0.1),
        'shift_mu': jax.random.uniform(ks[13], (L, SHIFT_WIDTH), F32),
        'w0': -1.0 + nrm(ks[14], (L, RWKV_WIDTH), 0.5),
        'w_w2': nrm(ks[15], (L, DECAY_LORA, RWKV_WIDTH), 0.1),
        'a0': nrm(ks[16], (L, RWKV_WIDTH), 0.1),
        'w_a2': nrm(ks[17], (L, ICLR_LORA, RWKV_WIDTH), 0.1),
        'k_k': 0.85 + nrm(ks[18], (L, RWKV_WIDTH), 0.05),
        'k_a': 1.0 + nrm(ks[19], (L, RWKV_WIDTH), 0.05),
        'r_k': nrm(ks[20], (L, RWKV_HEADS, HEAD_DIM), 0.1),
        'ln_x_g': 1.0 + nrm(ks[21], (L, RWKV_WIDTH), 0.1),
        'ln_x_b': nrm(ks[22], (L, RWKV_WIDTH), 0.01),
        'mem_norm_g': 1.0 + nrm(ks[23], (L, D_MODEL), 0.05),
        'w_kv': nrm(ks[24], (L, D_MODEL, 2 * XA_WIDTH), D_MODEL ** -0.5),
        'final_norm_g': 1.0 + nrm(ks[25], (D_MODEL,), 0.05),
    }


def reference(x_prompt, x_sample, mem_prompt, state_pool, state_shift, state_wkv, cache_mem_k, cache_mem_v,
              norm_g, w_in, w_out, pool_w, pool_scale, shift_mu, w0, w_w2, a0, w_a2, k_k, k_a, r_k,
              ln_x_g, ln_x_b, mem_norm_g, w_kv, final_norm_g):
    params = {'norm_g': norm_g, 'w_in': w_in, 'w_out': w_out, 'pool_w': pool_w, 'pool_scale': pool_scale,
              'shift_mu': shift_mu, 'w0': w0, 'w_w2': w_w2, 'a0': a0, 'w_a2': w_a2, 'k_k': k_k, 'k_a': k_a,
              'r_k': r_k, 'ln_x_g': ln_x_g, 'ln_x_b': ln_x_b, 'final_norm_g': final_norm_g}
    mk_list, mv_list = [], []
    for l in range(DEPTH):
        mk, mv = _mem_kv(mem_prompt, mem_norm_g[l], w_kv[l])
        mk_list.append(mk)
        mv_list.append(mv)
    memk_prompt = jnp.stack(mk_list)
    memv_prompt = jnp.stack(mv_list)
    dt = x_prompt.dtype
    pool0 = jnp.zeros((DEPTH, BATCH, POOL_BUF, POOL_WIDTH), dt)
    shift0 = jnp.zeros((DEPTH, BATCH, SHIFT_WIDTH), dt)
    wkv0 = jnp.zeros((DEPTH, BATCH, RWKV_HEADS, HEAD_DIM, HEAD_DIM), F32)
    y_prompt, pool_prompt, shift_prompt, wkv_prompt = _trunk(
        x_prompt, 0, pool0, shift0, wkv0, memk_prompt, memv_prompt, params)
    y_sample, pool_sample, shift_sample, wkv_sample = _trunk(
        x_sample, PAST_LEN, state_pool, state_shift, state_wkv, cache_mem_k, cache_mem_v, params)
    return (y_prompt, y_sample, pool_prompt, shift_prompt, wkv_prompt, memk_prompt, memv_prompt,
            pool_sample, shift_sample, wkv_sample)
```

```cpp
#include <hip/hip_runtime.h>
#include <hip/hip_cooperative_groups.h>
#include <cstdio>
namespace cg = cooperative_groups;

#ifndef DUPB1
#define DUPB1 0
#endif
#ifndef DUPMASK
#define DUPMASK 0
#endif
#ifndef MULTI_LAUNCH
#define MULTI_LAUNCH 0
#endif

typedef unsigned short u16;
typedef short bf16x8 __attribute__((ext_vector_type(8)));
typedef float f32x16 __attribute__((ext_vector_type(16)));
typedef float f32x4 __attribute__((ext_vector_type(4)));
typedef float f32x2 __attribute__((ext_vector_type(2)));
typedef unsigned u32x4 __attribute__((ext_vector_type(4)));
typedef unsigned u32x2 __attribute__((ext_vector_type(2)));

constexpr int D = 1024, NB = 8, T = 2048, NL = 4, DB = 128, NM = 256;
constexpr int PW = 256, PBUF = 15, RW = 512, RH = 8, XW = 256, XH = 4;
constexpr int SW = 1664, INW = 3200;
constexpr int MP = NB * T;
constexpr int MT = MP + DB;
constexpr int MPAD = 16640;
constexpr int C_POOLV = 0, C_POOLG = 256, C_RW = 512, C_RWG = 2176, C_Q = 2688, C_XAG = 2944;
constexpr size_t O_YP = 0;
constexpr size_t O_YS = O_YP + (size_t)MP * D;
constexpr size_t O_POOLP = O_YS + (size_t)DB * D;
constexpr size_t O_SHIFTP = O_POOLP + (size_t)NL * NB * PBUF * PW;
constexpr size_t O_WKVP = O_SHIFTP + (size_t)NL * NB * SW;
constexpr size_t O_MEMK = O_WKVP + (size_t)NL * NB * RH * 64 * 64;
constexpr size_t O_MEMV = O_MEMK + (size_t)NL * NB * NM * XW;
constexpr size_t O_POOLS = O_MEMV + (size_t)NL * NB * NM * XW;
constexpr size_t O_SHIFTS = O_POOLS + (size_t)NL * DB * PBUF * PW;
constexpr size_t O_WKVS = O_SHIFTS + (size_t)NL * DB * SW;
constexpr size_t W_WTIN = 0;
constexpr size_t W_WTOUT = W_WTIN + (size_t)NL * INW * D * 2;
constexpr size_t W_WTKV = W_WTOUT + (size_t)NL * D * D * 2;
constexpr size_t W_XN = W_WTKV + (size_t)NL * 512 * D * 2;
constexpr size_t W_MIX = W_XN + (size_t)MPAD * D * 2;
constexpr size_t W_MEMN = W_MIX + (size_t)MPAD * D * 2;
constexpr size_t W_H = W_MEMN + (size_t)NB * NM * D * 2;
constexpr size_t W_P = W_H + (size_t)MPAD * INW * 2;
constexpr size_t W_BONUS = W_P + (size_t)MT * RH * 384 * 4;
constexpr size_t W_YRAW = W_BONUS + (size_t)MT * RH * 16;
constexpr size_t W_KB = W_YRAW + (size_t)MT * RW * 4;
constexpr size_t W_VTB = W_KB + (size_t)NL * NB * NM * XW * 2;
constexpr size_t W_W2T = W_VTB + (size_t)NL * NB * NM * XW * 2;
constexpr size_t W_A2T = W_W2T + (size_t)NL * RW * 64 * 2;
constexpr size_t W_PWT = W_A2T + (size_t)NL * RW * 64 * 2;
constexpr size_t W_ROWSS = W_PWT + (size_t)NL * 4 * 64 * 64 * 2;
constexpr size_t W_BAR = W_ROWSS + (size_t)NL * MPAD * 4;
constexpr size_t W_END = W_BAR + 16384;

constexpr int LDS_BYTES = 147456;
static_assert((2 * 16 * 384 + 2 * 8 * 1024) * 4 <= LDS_BYTES, "scan LDS");
constexpr int NTHREADS = 512;

struct Params {
    const float *x_prompt, *x_sample, *mem_prompt, *state_pool, *state_shift, *state_wkv, *cache_k, *cache_v;
    const float *norm_g, *w_in, *w_out, *pool_w, *pool_scale, *shift_mu, *w0, *w_w2, *a0, *w_a2, *k_k, *k_a, *r_k, *ln_g, *ln_b, *mem_norm_g, *w_kv, *final_g;
    float* out;
    unsigned char* ws;
    int ph_lo, ph_hi;
};

#define LDS_BARRIER() do { asm volatile("s_waitcnt lgkmcnt(0)" ::: "memory"); __builtin_amdgcn_s_barrier(); asm volatile("" ::: "memory"); } while (0)
__device__ __forceinline__ int opaque_tid() { int t = threadIdx.x; asm volatile("" : "+v"(t)); return t; }
__device__ __forceinline__ u16 f2bf(float f) {
    unsigned u = __float_as_uint(f);
    u += 0x7fffu + ((u >> 16) & 1u);
    return (u16)(u >> 16);
}
__device__ __forceinline__ float bf2f(u16 h) { return __uint_as_float((unsigned)h << 16); }
__device__ __forceinline__ unsigned pk2(float a, float b) { unsigned r; asm("v_cvt_pk_bf16_f32 %0, %1, %2" : "=v"(r) : "v"(a), "v"(b)); return r; }
__device__ __forceinline__ float wave_max(float v) {
#pragma unroll
    for (int o = 1; o < 64; o <<= 1) v = fmaxf(v, __shfl_xor(v, o));
    return v;
}
__device__ __forceinline__ float silu(float x) { return x * __builtin_amdgcn_rcpf(1.f + __expf(-x)); }
template <int CTRL>
__device__ __forceinline__ float dpp_mov(float x) {
    return __int_as_float(__builtin_amdgcn_update_dpp(0, __float_as_int(x), CTRL, 0xf, 0xf, false));
}
__device__ __forceinline__ float row16_sum(float x) {
    x += dpp_mov<0xB1>(x);
    x += dpp_mov<0x4E>(x);
    x += dpp_mov<0x141>(x);
    x += dpp_mov<0x140>(x);
    return x;
}
__device__ __forceinline__ float wave_sum(float v) {
    v = row16_sum(v);
    v += __int_as_float(__builtin_amdgcn_update_dpp(0, __float_as_int(v), 0x142, 0xa, 0xf, false));
    v += __int_as_float(__builtin_amdgcn_update_dpp(0, __float_as_int(v), 0x143, 0xc, 0xf, false));
    return __int_as_float(__builtin_amdgcn_readlane(__float_as_int(v), 63));
}

__device__ __forceinline__ void norm_row(const float* src, float* xcopy, u16* dst, const float* gain_out, float* yout, int lane, float* ss_out = nullptr) {
    f32x4 v[4];
    float ss = 0.f;
#pragma unroll
    for (int j = 0; j < 4; ++j) {
        v[j] = *(const f32x4*)(src + (lane + 64 * j) * 4);
        ss += v[j].x * v[j].x + v[j].y * v[j].y + v[j].z * v[j].z + v[j].w * v[j].w;
    }
    ss = wave_sum(ss);
    const float rstd = ss_out ? 1.f : rsqrtf(ss * (1.f / D) + 1e-6f);
    if (ss_out && lane == 0) *ss_out = ss;
#pragma unroll
    for (int j = 0; j < 4; ++j) {
        const int o = (lane + 64 * j) * 4;
        if (xcopy) *(f32x4*)(xcopy + o) = v[j];
        if (dst) {
            u32x2 w;
            w.x = pk2(v[j].x * rstd, v[j].y * rstd);
            w.y = pk2(v[j].z * rstd, v[j].w * rstd);
            *(u32x2*)(dst + o) = w;
        }
        if (yout) {
            const f32x4 g = *(const f32x4*)(gain_out + o);
            f32x4 y;
            y.x = v[j].x * rstd * g.x; y.y = v[j].y * rstd * g.y; y.z = v[j].z * rstd * g.z; y.w = v[j].w * rstd * g.w;
            *(f32x4*)(yout + o) = y;
        }
    }
}

__device__ void phase0(const Params& p, unsigned char* lds, int bid, int nblk) {
    float* tile = (float*)lds;
    const int tid = opaque_tid();
    constexpr int IT_IN = 16 * 50, IT_OUT = 16 * 16, IT_KV = 16 * 8, IT_L = IT_IN + IT_OUT + IT_KV;
    struct TItem { const float* src; const float* g; u16* dst; int N, k0, n0; };
    auto item = [&](int it) {
        TItem t;
        const int l = it / IT_L;
        int r = it % IT_L;
        if (r < IT_IN) { t.src = p.w_in + (size_t)l * D * INW; t.g = p.norm_g + l * D; t.dst = (u16*)(p.ws + W_WTIN) + (size_t)l * INW * D; t.N = INW; }
        else if (r < IT_IN + IT_OUT) { r -= IT_IN; t.src = p.w_out + (size_t)l * D * D; t.g = nullptr; t.dst = (u16*)(p.ws + W_WTOUT) + (size_t)l * D * D; t.N = D; }
        else { r -= IT_IN + IT_OUT; t.src = p.w_kv + (size_t)l * D * 512; t.g = p.mem_norm_g + l * D; t.dst = (u16*)(p.ws + W_WTKV) + (size_t)l * 512 * D; t.N = 512; }
        const int nt = t.N / 64, kb = r / nt, nb = r % nt;
        t.k0 = kb * 64; t.n0 = nb * 64;
        return t;
    };
    const int tk = tid >> 4, tn4 = (tid & 15) * 4;
    f32x4 v[2]; float gg[2];
    auto tload = [&](const TItem& t) {
#pragma unroll
        for (int i = 0; i < 2; ++i) {
            const int k = tk + 32 * i;
            v[i] = *(const f32x4*)(t.src + (size_t)(t.k0 + k) * t.N + t.n0 + tn4);
            gg[i] = t.g ? t.g[t.k0 + k] : 1.f;
        }
    };
    if (bid < NL * IT_L) tload(item(bid));
#pragma unroll 1
    for (int it = bid; it < NL * IT_L; it += nblk) {
        const TItem t = item(it);
#pragma unroll
        for (int i = 0; i < 2; ++i) {
            const int k = tk + 32 * i;
            tile[k * 65 + tn4 + 0] = v[i].x * gg[i]; tile[k * 65 + tn4 + 1] = v[i].y * gg[i]; tile[k * 65 + tn4 + 2] = v[i].z * gg[i]; tile[k * 65 + tn4 + 3] = v[i].w * gg[i];
        }
        if (it + nblk < NL * IT_L) tload(item(it + nblk));
        LDS_BARRIER();
        {
            const int n = tid >> 3, kc = tid & 7;
            const float* s_ = tile + (kc * 8) * 65 + n;
            u32x4 o;
            o.x = pk2(s_[0 * 65], s_[1 * 65]); o.y = pk2(s_[2 * 65], s_[3 * 65]); o.z = pk2(s_[4 * 65], s_[5 * 65]); o.w = pk2(s_[6 * 65], s_[7 * 65]);
            *(u32x4*)(t.dst + (size_t)(t.n0 + n) * D + t.k0 + kc * 8) = o;
        }
        LDS_BARRIER();
    }
    const int wave = tid >> 6, lane = tid & 63;
    for (int row = bid * 8 + wave; row < MT + NB * NM; row += nblk * 8) {
        if (row < MT) {
            const float* src = row < MP ? p.x_prompt + (size_t)row * D : p.x_sample + (size_t)(row - MP) * D;
            norm_row(src, p.out + (size_t)row * D, (u16*)(p.ws + W_XN) + (size_t)row * D, nullptr, nullptr, lane, (float*)(p.ws + W_ROWSS) + row);
        } else {
            const int mr = row - MT;
            norm_row(p.mem_prompt + (size_t)mr * D, nullptr, (u16*)(p.ws + W_MEMN) + (size_t)mr * D, nullptr, nullptr, lane);
        }
    }
    for (int idx = bid * NTHREADS + tid; idx < (NL - 1) * MPAD; idx += nblk * NTHREADS) ((float*)(p.ws + W_ROWSS))[MPAD + idx] = 0.f;
    for (int idx = bid * NTHREADS + tid; idx < NL * 4 * 64 * 8; idx += nblk * NTHREADS) {
        const int lg_ = idx >> 9, e = (idx >> 3) & 63, kc = idx & 7;
        const float* src = p.pool_w + ((size_t)lg_ * 64 + kc * 8) * 64 + e;
        u32x4 o;
        o.x = pk2(src[0], src[64]); o.y = pk2(src[128], src[192]); o.z = pk2(src[256], src[320]); o.w = pk2(src[384], src[448]);
        *(u32x4*)((u16*)(p.ws + W_PWT) + ((size_t)lg_ * 64 + e) * 64 + kc * 8) = o;
    }
    for (int idx = bid * NTHREADS + tid; idx < 2 * NL * RW * 8; idx += nblk * NTHREADS) {
        const int which = idx / (NL * RW * 8), r = idx % (NL * RW * 8);
        const int l = r / (RW * 8), n = (r / 8) % RW, kc = r % 8;
        const float* src = (which ? p.w_a2 : p.w_w2) + (size_t)l * 64 * RW + (size_t)(kc * 8) * RW + n;
        u32x4 o;
        o.x = pk2(src[0], src[RW]); o.y = pk2(src[2 * RW], src[3 * RW]); o.z = pk2(src[4 * RW], src[5 * RW]); o.w = pk2(src[6 * RW], src[7 * RW]);
        *(u32x4*)((u16*)(p.ws + (which ? W_A2T : W_W2T)) + ((size_t)l * RW + n) * 64 + kc * 8) = o;
    }
}

constexpr int G_STAGE = 49152, G_AB = 32768;
#define RAW_BARRIER() do { asm volatile("s_waitcnt lgkmcnt(0)" ::: "memory"); __builtin_amdgcn_s_barrier(); asm volatile("" ::: "memory"); } while (0)
template <class Epi>
__device__ __forceinline__ void gemm_tile(const u16* __restrict__ A, const u16* __restrict__ Bt, int m0, int n0, unsigned char* lds, const Epi& epi) {
    const int tid = opaque_tid(), wave = tid >> 6, lane = tid & 63;
    const int wm = wave >> 1, wn = wave & 1;
    const int lr = lane & 31, lh = lane >> 5;
    f32x16 acc[2][2];
#pragma unroll
    for (int i = 0; i < 2; ++i)
#pragma unroll
        for (int j = 0; j < 2; ++j)
#pragma unroll
            for (int e = 0; e < 16; ++e) acc[i][j][e] = 0.f;
    const int lrow = lane >> 3, cpos = lane & 7;
    const u16* ga[4]; const u16* gb[2];
#pragma unroll
    for (int i = 0; i < 4; ++i) { const int row = (wave * 4 + i) * 8 + lrow; ga[i] = A + (size_t)(m0 + row) * D + ((cpos ^ ((row >> 1) & 7)) << 3); }
#pragma unroll
    for (int i = 0; i < 2; ++i) { const int row = (wave * 2 + i) * 8 + lrow; gb[i] = Bt + (size_t)(n0 + row) * D + ((cpos ^ ((row >> 1) & 7)) << 3); }
    auto glds = [&](int kt, int st) {
#pragma unroll
        for (int i = 0; i < 4; ++i) __builtin_amdgcn_global_load_lds((const unsigned*)(ga[i] + kt * 64), (__attribute__((address_space(3))) unsigned*)(lds + st * G_STAGE + (wave * 4 + i) * 1024), 16, 0, 0);
#pragma unroll
        for (int i = 0; i < 2; ++i) __builtin_amdgcn_global_load_lds((const unsigned*)(gb[i] + kt * 64), (__attribute__((address_space(3))) unsigned*)(lds + st * G_STAGE + G_AB + (wave * 2 + i) * 1024), 16, 0, 0);
    };
    int aoff[2], asw[2], boff[2], bsw[2];
#pragma unroll
    for (int i = 0; i < 2; ++i) { const int row = wm * 64 + i * 32 + lr; aoff[i] = row * 128; asw[i] = (row >> 1) & 7; }
#pragma unroll
    for (int j = 0; j < 2; ++j) { const int row = wn * 64 + j * 32 + lr; boff[j] = G_AB + row * 128; bsw[j] = (row >> 1) & 7; }
    asm volatile("s_waitcnt vmcnt(0)" ::: "memory");
    RAW_BARRIER();
    glds(0, 0); glds(1, 1);
    for (int kt = 0; kt < 16; ++kt) {
        if (kt + 1 < 16) asm volatile("s_waitcnt vmcnt(6)" ::: "memory"); else asm volatile("s_waitcnt vmcnt(0)" ::: "memory");
        RAW_BARRIER();
        if (kt + 2 < 16) glds(kt + 2, (kt + 2) % 3);
        const unsigned char* sb = lds + (kt % 3) * G_STAGE;
        bf16x8 af[2][2], bfr[2][2];
#pragma unroll
        for (int i = 0; i < 2; ++i) af[0][i] = *(const bf16x8*)(sb + aoff[i] + (((lh) ^ asw[i]) << 4));
#pragma unroll
        for (int j = 0; j < 2; ++j) bfr[0][j] = *(const bf16x8*)(sb + boff[j] + (((lh) ^ bsw[j]) << 4));
#pragma unroll
        for (int ks = 0; ks < 4; ++ks) {
            if (ks + 1 < 4) {
#pragma unroll
                for (int i = 0; i < 2; ++i) af[(ks + 1) & 1][i] = *(const bf16x8*)(sb + aoff[i] + (((2 * (ks + 1) + lh) ^ asw[i]) << 4));
#pragma unroll
                for (int j = 0; j < 2; ++j) bfr[(ks + 1) & 1][j] = *(const bf16x8*)(sb + boff[j] + (((2 * (ks + 1) + lh) ^ bsw[j]) << 4));
            }
#pragma unroll
            for (int i = 0; i < 2; ++i)
#pragma unroll
                for (int j = 0; j < 2; ++j) acc[i][j] = __builtin_amdgcn_mfma_f32_32x32x16_bf16(bfr[ks & 1][j], af[ks & 1][i], acc[i][j], 0, 0, 0);
        }
    }
    if constexpr (Epi::MODE == 0) {
#pragma unroll
        for (int i = 0; i < 2; ++i) {
            const int m = m0 + wm * 64 + i * 32 + lr;
#pragma unroll
            for (int j = 0; j < 2; ++j)
#pragma unroll
                for (int g = 0; g < 4; ++g) {
                    const int n = n0 + wn * 64 + j * 32 + 8 * g + 4 * lh;
                    f32x4 v;
                    v.x = acc[i][j][4 * g + 0]; v.y = acc[i][j][4 * g + 1]; v.z = acc[i][j][4 * g + 2]; v.w = acc[i][j][4 * g + 3];
                    epi(m, n, v);
                }
        }
    } else if constexpr (Epi::MODE == 1) {
        RAW_BARRIER();
        u16* Cs = (u16*)lds;
#pragma unroll
        for (int i = 0; i < 2; ++i) {
            const int row = wm * 64 + i * 32 + lr;
            const float rs = epi.row_scale(m0 + row);
#pragma unroll
            for (int j = 0; j < 2; ++j)
#pragma unroll
                for (int g = 0; g < 4; ++g) {
                    const int col = wn * 64 + j * 32 + 8 * g + 4 * lh;
                    u32x2 w; w.x = pk2(acc[i][j][4 * g + 0] * rs, acc[i][j][4 * g + 1] * rs); w.y = pk2(acc[i][j][4 * g + 2] * rs, acc[i][j][4 * g + 3] * rs);
                    *(u32x2*)(Cs + row * 136 + col) = w;
                }
        }
        RAW_BARRIER();
#pragma unroll
        for (int k = 0; k < 8; ++k) {
            const int id = tid + 512 * k, row = id >> 4, ch = id & 15;
            const u32x4 v = *(const u32x4*)(Cs + row * 136 + ch * 8);
            epi.store_row16(m0 + row, n0 + ch * 8, v);
        }
    } else {
        RAW_BARRIER();
        float* Cs = (float*)lds;
#pragma unroll
        for (int i = 0; i < 2; ++i) {
            const int row = wm * 64 + i * 32 + lr;
#pragma unroll
            for (int j = 0; j < 2; ++j)
#pragma unroll
                for (int g = 0; g < 4; ++g) {
                    const int col = wn * 64 + j * 32 + 8 * g + 4 * lh;
                    f32x4 v;
                    v.x = acc[i][j][4 * g + 0]; v.y = acc[i][j][4 * g + 1]; v.z = acc[i][j][4 * g + 2]; v.w = acc[i][j][4 * g + 3];
                    *(f32x4*)(Cs + row * 132 + col) = v;
                }
        }
        RAW_BARRIER();
#pragma unroll 4
        for (int k = 0; k < 16; ++k) {
            const int id = tid + 512 * k, row = id >> 5, ch = id & 31;
            const f32x4 v = *(const f32x4*)(Cs + row * 132 + ch * 4);
            epi.add_row16(m0 + row, n0 + ch * 4, v, ch);
        }
    }
}

struct EpiH {
    static constexpr int MODE = 1;
    u16* h; const float* rowss;
    __device__ __forceinline__ float row_scale(int m) const { return m < MT ? rsqrtf(rowss[m] * (1.f / D) + 1e-6f) : 0.f; }
    __device__ __forceinline__ void store_row16(int m, int n, u32x4 v) const { if (m < MT) *(u32x4*)(h + (size_t)m * INW + n) = v; }
};
struct EpiKV {
    float* mk; float* mv; u16* kb; u16* vtb;
    static constexpr int MODE = 0;
    __device__ __forceinline__ void operator()(int m, int n, f32x4 v) const {
        float* dst = n < XW ? mk + (size_t)m * XW + n : mv + (size_t)m * XW + (n - XW);
        *(f32x4*)dst = v;
        const int b = m >> 8, mm = m & 255;
        if (n < XW) {
            const int head = n >> 6, d = n & 63;
            u32x2 w; w.x = pk2(v.x, v.y); w.y = pk2(v.z, v.w);
            *(u32x2*)(kb + ((size_t)(b * XH + head) * NM + mm) * 64 + d) = w;
        } else {
            const int n2 = n - XW, head = n2 >> 6, d = n2 & 63;
            u16* q = vtb + ((size_t)(b * XH + head) * 64 + d) * NM + mm;
            q[0] = f2bf(v.x); q[NM] = f2bf(v.y); q[2 * NM] = f2bf(v.z); q[3 * NM] = f2bf(v.w);
        }
    }
};
struct EpiRes {
    static constexpr int MODE = 2;
    float* x; u16* xb; float* rowss;
    __device__ __forceinline__ void add_row16(int m, int n, f32x4 v, int ch) const {
        float s = 0.f;
        if (m < MT) {
            f32x4* q = (f32x4*)(x + (size_t)m * D + n); f32x4 o = *q; o.x += v.x; o.y += v.y; o.z += v.z; o.w += v.w; *q = o;
            if (xb) { u32x2 w; w.x = pk2(o.x, o.y); w.y = pk2(o.z, o.w); *(u32x2*)(xb + (size_t)m * D + n) = w; s = o.x * o.x + o.y * o.y + o.z * o.z + o.w * o.w; }
        }
        if (rowss) { s = row16_sum(s); s += __shfl_xor(s, 16); if (ch == 0 && m < MT) atomicAdd(rowss + m, s); }
    }
};

__device__ void phaseA(const Params& p, int l, unsigned char* lds, int bid, int nblk) {
    if ((nblk & 7) == 0) {
        const int per = nblk >> 3, xcd = bid / per, j = bid % per;
        const int n_extra = xcd < 7 ? 8 : 9;
        const int n_main = 195 + n_extra;
        const int n_kv = l == 0 ? 16 : 0;
        for (int li = j; li < n_main + n_kv; li += per) {
            if (li < n_main) {
                int mt, nt;
                if (li < 195) { mt = li / 3; nt = xcd + 8 * (li % 3); } else { mt = 8 * xcd + (li - 195); nt = 24; }
                EpiH e{(u16*)(p.ws + W_H), (const float*)(p.ws + W_ROWSS) + (size_t)l * MPAD};
                gemm_tile((const u16*)(p.ws + W_XN), (const u16*)(p.ws + W_WTIN) + (size_t)l * INW * D, mt * 256, nt * 128, lds, e);
            } else {
                const int r = (li - n_main) * 8 + xcd, ll = r / 32, mt = (r % 32) / 4, nt = r % 4;
                EpiKV e{p.out + O_MEMK + (size_t)ll * NB * NM * XW, p.out + O_MEMV + (size_t)ll * NB * NM * XW, (u16*)(p.ws + W_KB) + (size_t)ll * NB * NM * XW, (u16*)(p.ws + W_VTB) + (size_t)ll * NB * NM * XW};
                gemm_tile((const u16*)(p.ws + W_MEMN), (const u16*)(p.ws + W_WTKV) + (size_t)ll * 512 * D, mt * 256, nt * 128, lds, e);
            }
        }
        return;
    }
    constexpr int NT_IN = 65 * 25;
    const int nitems = NT_IN + (l == 0 ? NL * 8 * 4 : 0);
    for (int it = bid; it < nitems; it += nblk) {
        if (it < NT_IN) {
            const int mt = it / 25, nt = it % 25;
            EpiH e{(u16*)(p.ws + W_H), (const float*)(p.ws + W_ROWSS) + (size_t)l * MPAD};
            gemm_tile((const u16*)(p.ws + W_XN), (const u16*)(p.ws + W_WTIN) + (size_t)l * INW * D, mt * 256, nt * 128, lds, e);
        } else {
            const int r = it - NT_IN, ll = r / 32, mt = (r % 32) / 4, nt = r % 4;
            EpiKV e{p.out + O_MEMK + (size_t)ll * NB * NM * XW, p.out + O_MEMV + (size_t)ll * NB * NM * XW, (u16*)(p.ws + W_KB) + (size_t)ll * NB * NM * XW, (u16*)(p.ws + W_VTB) + (size_t)ll * NB * NM * XW};
            gemm_tile((const u16*)(p.ws + W_MEMN), (const u16*)(p.ws + W_WTKV) + (size_t)ll * 512 * D, mt * 256, nt * 128, lds, e);
        }
    }
}
__device__ void phaseC(const Params& p, int l, unsigned char* lds, int bid, int nblk) {
    EpiRes e{p.out, l < NL - 1 ? (u16*)(p.ws + W_XN) : nullptr, l < NL - 1 ? (float*)(p.ws + W_ROWSS) + (size_t)(l + 1) * MPAD : nullptr};
    if ((nblk & 7) == 0 && nblk > 16) {
        const int per = nblk >> 3, xcd = bid / per, j = bid % per;
        for (int mt = j; mt < 64; mt += per) gemm_tile((const u16*)(p.ws + W_MIX), (const u16*)(p.ws + W_WTOUT) + (size_t)l * D * D, mt * 256, xcd * 128, lds, e);
        return;
    }
    for (int it = bid; it < (nblk > 16 ? 64 : 65) * 8; it += nblk) {
        const int mt = it / 8, nt = it % 8;
        gemm_tile((const u16*)(p.ws + W_MIX), (const u16*)(p.ws + W_WTOUT) + (size_t)l * D * D, mt * 256, nt * 128, lds, e);
    }
}
__device__ void phaseN(const Params& p, int l, int bid, int nblk) {
    const int tid_ = opaque_tid(); const int wave = tid_ >> 6, lane = tid_ & 63;
    f32x4 g[4];
#pragma unroll
    for (int j = 0; j < 4; ++j) g[j] = *(const f32x4*)(p.final_g + (lane + 64 * j) * 4);
#pragma unroll 1
    for (int row0 = (bid * 8 + wave) * 4; row0 < MT; row0 += nblk * 8 * 4) {
        f32x4 v[4][4];
#pragma unroll
        for (int r = 0; r < 4; ++r)
#pragma unroll
            for (int j = 0; j < 4; ++j) v[r][j] = *(const f32x4*)(p.out + (size_t)(row0 + r) * D + (lane + 64 * j) * 4);
#pragma unroll
        for (int r = 0; r < 4; ++r) {
            float ss = 0.f;
#pragma unroll
            for (int j = 0; j < 4; ++j) ss += v[r][j].x * v[r][j].x + v[r][j].y * v[r][j].y + v[r][j].z * v[r][j].z + v[r][j].w * v[r][j].w;
            ss = wave_sum(ss);
            const float rstd = rsqrtf(ss * (1.f / D) + 1e-6f);
#pragma unroll
            for (int j = 0; j < 4; ++j) {
                f32x4 y;
                y.x = v[r][j].x * rstd * g[j].x; y.y = v[r][j].y * rstd * g[j].y; y.z = v[r][j].z * rstd * g[j].z; y.w = v[r][j].w * rstd * g[j].w;
                *(f32x4*)(p.out + (size_t)(row0 + r) * D + (lane + 64 * j) * 4) = y;
            }
        }
    }
}

__device__ __forceinline__ size_t p_index(int row, int head) {
    return row < MP ? ((size_t)((row >> 11) * RH + head) * T + (row & (T - 1))) * 384 : ((size_t)row * RH + head) * 384;
}
__device__ __forceinline__ f32x4 bf4(u32x2 v) {
    f32x4 o; o.x = __uint_as_float(v.x << 16); o.y = __uint_as_float(v.x & 0xffff0000u); o.z = __uint_as_float(v.y << 16); o.w = __uint_as_float(v.y & 0xffff0000u);
    return o;
}
__device__ __forceinline__ f32x4 ld_bf4(const u16* p) {
    const u32x2 v = *(const u32x2*)p;
    f32x4 o; o.x = __uint_as_float(v.x << 16); o.y = __uint_as_float(v.x & 0xffff0000u); o.z = __uint_as_float(v.y << 16); o.w = __uint_as_float(v.y & 0xffff0000u);
    return o;
}
struct PrepFrags { const u16* W2T; const u16* A2T; };
__device__ __forceinline__ void prep_item(const Params& p, int l, int ti, unsigned char* lds, const PrepFrags& fr, const float* cst) {
    u16* twb = (u16*)lds;
    u16* adb = twb + 16 * 72;
    const int tid = opaque_tid(), head = tid >> 6, lane = tid & 63;
    const u16* H = (const u16*)(p.ws + W_H);
    const bool dec = ti >= MP / 16;
    const int r0 = dec ? MP + (ti - MP / 16) * 16 : ti * 16;
    const bool first = !dec && (r0 % T == 0);
    const float* mu = p.shift_mu + l * SW;
    const float* sshift = p.state_shift + (size_t)l * DB * SW;
    const int m = lane & 15, g = lane >> 4;
    const int row = r0 + m;
    const bool noprev = first && m == 0;
    u32x2 hc[4][3];
#pragma unroll
    for (int nt = 0; nt < 4; ++nt) {
        const u16* hp = H + (size_t)row * INW + C_RW + head * 64 + nt * 16 + 4 * g;
#pragma unroll
        for (int j = 0; j < 3; ++j) hc[nt][j] = *(const u32x2*)(hp + 512 * j);
    }
    __syncthreads();
#pragma unroll
    for (int i = 0; i < 4; ++i) {
        const int idx = tid + 512 * i, tt = idx >> 7, col = idx & 127;
        const int row = r0 + tt;
        const float cur = bf2f(H[(size_t)row * INW + C_RW + 1536 + col]);
        float prev;
        if (dec) prev = sshift[(size_t)(row - MP) * SW + 1536 + col];
        else prev = (tt == 0 && first) ? 0.f : bf2f(H[(size_t)(row - 1) * INW + C_RW + 1536 + col]);
        const float val = cur + (prev - cur) * mu[1536 + col];
        if (col < 64) { const float e = __expf(2.f * val); twb[tt * 72 + col] = f2bf(1.f - 2.f / (e + 1.f)); }
        else adb[tt * 72 + col - 64] = f2bf(val);
    }
    __syncthreads();
    bf16x8 btw[2], bad[2];
#pragma unroll
    for (int ks = 0; ks < 2; ++ks) { btw[ks] = *(const bf16x8*)(twb + m * 72 + ks * 32 + 8 * g); bad[ks] = *(const bf16x8*)(adb + m * 72 + ks * 32 + 8 * g); }
    float* Pp = (float*)(p.ws + W_P) + p_index(row, head);
    f32x4 kkv[4], av[4], wrv[4];
    float ss = 0.f, sbon = 0.f, sc1 = 0.f, sc2 = 0.f;
#pragma unroll
    for (int nt = 0; nt < 4; ++nt) {
        const int cl = nt * 16 + 4 * g;
        const int c = head * 64 + cl;
        f32x4 accw = {0.f, 0.f, 0.f, 0.f}, acca = {0.f, 0.f, 0.f, 0.f};
#pragma unroll
        for (int ks = 0; ks < 2; ++ks) {
            const bf16x8 aw = *(const bf16x8*)(fr.W2T + (size_t)(nt * 16 + m) * 64 + ks * 32 + 8 * g);
            const bf16x8 aa = *(const bf16x8*)(fr.A2T + (size_t)(nt * 16 + m) * 64 + ks * 32 + 8 * g);
            accw = __builtin_amdgcn_mfma_f32_16x16x32_bf16(aw, btw[ks], accw, 0, 0, 0);
            acca = __builtin_amdgcn_mfma_f32_16x16x32_bf16(aa, bad[ks], acca, 0, 0, 0);
        }
        const f32x4 w0v = *(const f32x4*)(cst + cl), a0v = *(const f32x4*)(cst + 64 + cl);
        const f32x4 kkc = *(const f32x4*)(cst + 128 + cl), kac = *(const f32x4*)(cst + 192 + cl), rkc = *(const f32x4*)(cst + 256 + cl);
        const f32x4 mr = *(const f32x4*)(cst + 320 + cl), mk = *(const f32x4*)(cst + 384 + cl), mv = *(const f32x4*)(cst + 448 + cl);
        const f32x4 cr = bf4(hc[nt][0]), ck = bf4(hc[nt][1]), cv = bf4(hc[nt][2]);
        f32x4 pr, pk, pv;
        if (dec) { const float* sp = sshift + (size_t)(row - MP) * SW + c; pr = *(const f32x4*)sp; pk = *(const f32x4*)(sp + 512); pv = *(const f32x4*)(sp + 1024); }
        else if (noprev) { pr = (f32x4){0.f, 0.f, 0.f, 0.f}; pk = pr; pv = pr; }
        else { const u16* hq = H + (size_t)(row - 1) * INW + C_RW + c; pr = ld_bf4(hq); pk = ld_bf4(hq + 512); pv = ld_bf4(hq + 1024); }
        f32x4 o_dec, o_k2, o_wr, o_v;
#pragma unroll
        for (int i = 0; i < 4; ++i) {
            const float rr = cr[i] + (pr[i] - cr[i]) * mr[i], kq = ck[i] + (pk[i] - ck[i]) * mk[i], vv = cv[i] + (pv[i] - cv[i]) * mv[i];
            const float z = -(accw[i] + w0v[i]);
            const float sp_ = fmaxf(z, 0.f) + __logf(1.f + __expf(-fabsf(z)));
            const float decay = __expf(-__expf(-sp_ - 0.5f));
            const float a = __builtin_amdgcn_rcpf(1.f + __expf(-(acca[i] + a0v[i])));
            const float kv_ = kq * kkc[i];
            const float k2 = kq * (1.f + (a - 1.f) * kac[i]);
            kkv[nt][i] = kv_; av[nt][i] = a;
            ss += kv_ * kv_; sbon += rr * k2 * rkc[i]; sc1 += kv_ * a * rr; sc2 += k2 * rr;
            o_dec[i] = decay; o_k2[i] = k2; o_wr[i] = decay * rr; o_v[i] = vv;
        }
        wrv[nt] = o_wr;
        __builtin_nontemporal_store(o_dec, (f32x4*)(Pp + cl)); __builtin_nontemporal_store(o_k2, (f32x4*)(Pp + 192 + cl)); __builtin_nontemporal_store(o_v, (f32x4*)(Pp + 320 + cl));
    }
    ss += __shfl_xor(ss, 16); sbon += __shfl_xor(sbon, 16); sc1 += __shfl_xor(sc1, 16); sc2 += __shfl_xor(sc2, 16);
    ss += __shfl_xor(ss, 32); sbon += __shfl_xor(sbon, 32); sc1 += __shfl_xor(sc1, 32); sc2 += __shfl_xor(sc2, 32);
    const float rn = 1.f / fmaxf(sqrtf(ss), 1e-12f);
    const float c1 = sc1 * rn;
#pragma unroll
    for (int nt = 0; nt < 4; ++nt) {
        const int cl = nt * 16 + 4 * g;
        f32x4 o_kk, o_ka;
#pragma unroll
        for (int i = 0; i < 4; ++i) { o_kk[i] = kkv[nt][i] * rn; o_ka[i] = o_kk[i] * av[nt][i]; wrv[nt][i] -= c1 * o_kk[i]; }
        __builtin_nontemporal_store(o_kk, (f32x4*)(Pp + 64 + cl)); __builtin_nontemporal_store(o_ka, (f32x4*)(Pp + 128 + cl)); __builtin_nontemporal_store(wrv[nt], (f32x4*)(Pp + 256 + cl));
    }
    if (g == 0) { f32x4 bv; bv.x = sbon; bv.y = sc1 * rn; bv.z = sc2; bv.w = 0.f; *(f32x4*)((float*)(p.ws + W_BONUS) + ((size_t)row * RH + head) * 4) = bv; }
    if (dec) {
        for (int idx = tid; idx < 16 * SW; idx += 512) {
            const int tt = idx / SW, col = idx % SW;
            const int s_ = r0 - MP + tt;
            p.out[O_SHIFTS + ((size_t)l * DB + s_) * SW + col] = bf2f(H[(size_t)(r0 + tt) * INW + C_RW + col]);
        }
    } else if ((r0 % T) == T - 16) {
        const int b = r0 / T;
        for (int col = tid; col < SW; col += 512)
            p.out[O_SHIFTP + ((size_t)l * NB + b) * SW + col] = bf2f(H[(size_t)(r0 + 15) * INW + C_RW + col]);
    }
}

__device__ void pool_item(const Params& p, int l, int ti, unsigned char* lds) {
    float* pv = (float*)lds;
    u16* pooled = (u16*)(pv + 47 * 256);
    const int tid = opaque_tid();
    const u16* H = (const u16*)(p.ws + W_H);
    const bool dec = ti >= MP / 32;
    const int r0 = dec ? MP + (ti - MP / 32) * 32 : ti * 32;
    const int col = tid & 255, half = tid >> 8;
    const int g = col >> 6, win = 2 << g;
    __syncthreads();
    if (!dec) {
        const int t0 = r0 % T;
        {
            u32x2 ld[6];
#pragma unroll
            for (int i = 0; i < 6; ++i) {
                const int idx = tid + 512 * i, rr = min(idx >> 6, 46), ch = idx & 63;
                const int t = t0 - 15 + rr;
                const int rowc = t >= 0 ? r0 - 15 + rr : r0;
                ld[i] = *(const u32x2*)(H + (size_t)rowc * INW + C_POOLV + ch * 4);
            }
#pragma unroll
            for (int i = 0; i < 6; ++i) {
                const int idx = tid + 512 * i, rr = idx >> 6, ch = idx & 63;
                const bool ok = (t0 - 15 + rr) >= 0;
                if (rr < 47) {
                    f32x4 v;
                    v.x = ok ? __uint_as_float(ld[i].x << 16) : 0.f; v.y = ok ? __uint_as_float(ld[i].x & 0xffff0000u) : 0.f;
                    v.z = ok ? __uint_as_float(ld[i].y << 16) : 0.f; v.w = ok ? __uint_as_float(ld[i].y & 0xffff0000u) : 0.f;
                    *(f32x4*)(pv + rr * 256 + ch * 4) = v;
                }
            }
        }
        __syncthreads();
        {
            const float* pc = pv + (15 + half * 16) * 256 + col;
            float sw = 0.f;
            for (int k = 1; k < win; ++k) sw += pc[-k * 256];
            const float rw_ = 1.f / (float)win;
#pragma unroll
            for (int i = 0; i < 16; ++i) {
                const int tt = half * 16 + i;
                const float cur = pc[i * 256];
                sw += cur;
                const int pos1 = t0 + tt + 1;
                const float inv = pos1 >= win ? rw_ : 1.f / (float)pos1;
                pooled[tt * 264 + col] = f2bf(sw * inv - cur);
                sw -= pc[(i - win + 1) * 256];
            }
        }
        if (t0 == T - 32) {
            const int b = r0 / T;
            for (int idx = tid; idx < 15 * 256; idx += 512)
                p.out[O_POOLP + ((size_t)l * NB + b) * PBUF * PW + idx] = pv[(32 + (idx >> 8)) * 256 + (idx & 255)];
        }
    } else {
#pragma unroll 1
        for (int i0 = 0; i0 < 16; i0 += 4) {
            float sv[4][15], cu[4];
#pragma unroll
            for (int j = 0; j < 4; ++j) {
                const int tt = half * 16 + i0 + j, s_ = r0 - MP + tt;
                const float* sp = p.state_pool + ((size_t)l * DB + s_) * PBUF * PW + col;
#pragma unroll
                for (int k = 0; k < 15; ++k) sv[j][k] = sp[(size_t)k * PW];
                cu[j] = bf2f(H[(size_t)(r0 + tt) * INW + C_POOLV + col]);
            }
#pragma unroll
            for (int j = 0; j < 4; ++j) {
                const int tt = half * 16 + i0 + j, s_ = r0 - MP + tt;
                float* op = p.out + O_POOLS + ((size_t)l * DB + s_) * PBUF * PW + col;
                float sum = cu[j];
#pragma unroll
                for (int k = 0; k < 15; ++k) {
                    if (k >= 1) op[(size_t)(k - 1) * PW] = sv[j][k];
                    sum += (k >= 16 - win) ? sv[j][k] : 0.f;
                }
                op[(size_t)14 * PW] = cu[j];
                pooled[tt * 264 + col] = f2bf(sum / (float)win - cu[j]);
            }
        }
    }
    __syncthreads();
    {
        const int wave = tid >> 6, lane = tid & 63, lr = lane & 31, lh = lane >> 5;
        const int gg = wave >> 1, nh = wave & 1;
        const u16* PWT = (const u16*)(p.ws + W_PWT) + ((size_t)(l * 4 + gg) * 64 + nh * 32 + lr) * 64 + 8 * lh;
        f32x16 acc;
#pragma unroll
        for (int e = 0; e < 16; ++e) acc[e] = 0.f;
#pragma unroll
        for (int ks = 0; ks < 4; ++ks) {
            const bf16x8 a = *(const bf16x8*)(PWT + ks * 16);
            const bf16x8 bq = *(const bf16x8*)(pooled + lr * 264 + gg * 64 + ks * 16 + 8 * lh);
            acc = __builtin_amdgcn_mfma_f32_32x32x16_bf16(a, bq, acc, 0, 0, 0);
        }
        const int row = r0 + lr;
        u16* MIX = (u16*)(p.ws + W_MIX);
#pragma unroll
        for (int q = 0; q < 4; ++q) {
            const int cc = gg * 64 + nh * 32 + 8 * q + 4 * lh;
            const f32x4 sc = *(const f32x4*)(p.pool_scale + l * PW + cc);
            const f32x4 gt = ld_bf4(H + (size_t)row * INW + C_POOLG + cc);
            u32x2 o;
            o.x = pk2(acc[4 * q + 0] * sc.x * silu(gt.x), acc[4 * q + 1] * sc.y * silu(gt.y));
            o.y = pk2(acc[4 * q + 2] * sc.z * silu(gt.z), acc[4 * q + 3] * sc.w * silu(gt.w));
            *(u32x2*)(MIX + (size_t)row * D + cc) = o;
        }
    }
}

constexpr int KLD = 72, VLD = 264;
__device__ void xattn_prompt_item(const Params& p, int l, int it, unsigned char* lds) {
    u16* Ks = (u16*)lds;
    u16* Vt = Ks + 256 * KLD;
    const int tid = opaque_tid(), wave = tid >> 6, lane = tid & 63;
    const int b = it >> 6, head = (it >> 4) & 3, qc = it & 15;
    const u16* KB = (const u16*)(p.ws + W_KB) + ((size_t)((l * NB + b) * XH + head) * NM) * 64;
    const u16* VTB = (const u16*)(p.ws + W_VTB) + ((size_t)((l * NB + b) * XH + head) * 64) * NM;
    __syncthreads();
#pragma unroll
    for (int i = 0; i < 4; ++i) {
        const int idx = tid + 512 * i;
        const int m = idx >> 3, ch = idx & 7;
        *(u32x4*)(Ks + m * KLD + ch * 8) = *(const u32x4*)(KB + m * 64 + ch * 8);
        const int d = idx >> 5, cv = idx & 31;
        *(u32x4*)(Vt + d * VLD + cv * 8) = *(const u32x4*)(VTB + d * NM + cv * 8);
    }
    __syncthreads();
    const u16* H = (const u16*)(p.ws + W_H);
    const int lq = lane & 15, lg = lane >> 4;
    const int row = b * T + qc * 128 + wave * 16 + lq;
    bf16x8 qf[2];
#pragma unroll
    for (int ks = 0; ks < 2; ++ks) qf[ks] = *(const bf16x8*)(H + (size_t)row * INW + C_Q + head * 64 + ks * 32 + 8 * lg);
    f32x4 st[16];
#pragma unroll
    for (int kt = 0; kt < 16; ++kt) {
        f32x4 acc = {0.f, 0.f, 0.f, 0.f};
#pragma unroll
        for (int ks = 0; ks < 2; ++ks) {
            const bf16x8 a = *(const bf16x8*)(Ks + (kt * 16 + lq) * KLD + ks * 32 + 8 * lg);
            acc = __builtin_amdgcn_mfma_f32_16x16x32_bf16(a, qf[ks], acc, 0, 0, 0);
        }
        st[kt] = acc;
    }
    float mx = -1e30f;
#pragma unroll
    for (int kt = 0; kt < 16; ++kt) mx = fmaxf(mx, fmaxf(fmaxf(st[kt].x, st[kt].y), fmaxf(st[kt].z, st[kt].w)));
    mx = fmaxf(mx, __shfl_xor(mx, 16)); mx = fmaxf(mx, __shfl_xor(mx, 32));
    float sum = 0.f;
#pragma unroll
    for (int kt = 0; kt < 16; ++kt) {
        st[kt].x = __expf((st[kt].x - mx) * 0.125f); st[kt].y = __expf((st[kt].y - mx) * 0.125f);
        st[kt].z = __expf((st[kt].z - mx) * 0.125f); st[kt].w = __expf((st[kt].w - mx) * 0.125f);
        sum += st[kt].x + st[kt].y + st[kt].z + st[kt].w;
    }
    sum += __shfl_xor(sum, 16); sum += __shfl_xor(sum, 32);
    const float inv = 1.f / sum;
    f32x4 ao[4];
#pragma unroll
    for (int dt = 0; dt < 4; ++dt) ao[dt] = (f32x4){0.f, 0.f, 0.f, 0.f};
#pragma unroll
    for (int m = 0; m < 8; ++m) {
        u32x4 pb;
        pb.x = pk2(st[2 * m].x, st[2 * m].y); pb.y = pk2(st[2 * m].z, st[2 * m].w);
        pb.z = pk2(st[2 * m + 1].x, st[2 * m + 1].y); pb.w = pk2(st[2 * m + 1].z, st[2 * m + 1].w);
        const bf16x8 pf = __builtin_bit_cast(bf16x8, pb);
#pragma unroll
        for (int dt = 0; dt < 4; ++dt) {
            const u16* vp = Vt + (dt * 16 + lq) * VLD + 32 * m + 4 * lg;
            u32x4 av;
            const u32x2 lo = *(const u32x2*)vp, hi = *(const u32x2*)(vp + 16);
            av.x = lo.x; av.y = lo.y; av.z = hi.x; av.w = hi.y;
            ao[dt] = __builtin_amdgcn_mfma_f32_16x16x32_bf16(__builtin_bit_cast(bf16x8, av), pf, ao[dt], 0, 0, 0);
        }
    }
    u16* MIX = (u16*)(p.ws + W_MIX);
#pragma unroll
    for (int dt = 0; dt < 4; ++dt) {
        const int d = dt * 16 + 4 * lg;
        const u32x2 gv = *(const u32x2*)(H + (size_t)row * INW + C_XAG + head * 64 + d);
        const float g0 = __uint_as_float(gv.x << 16), g1 = __uint_as_float(gv.x & 0xffff0000u), g2 = __uint_as_float(gv.y << 16), g3 = __uint_as_float(gv.y & 0xffff0000u);
        u32x2 o;
        o.x = pk2(ao[dt].x * inv * silu(g0), ao[dt].y * inv * silu(g1));
        o.y = pk2(ao[dt].z * inv * silu(g2), ao[dt].w * inv * silu(g3));
        *(u32x2*)(MIX + (size_t)row * D + 768 + head * 64 + d) = o;
    }
}

__device__ void xattn_decode_item(const Params& p, int l, int it, unsigned char* lds) {
    const int tid = opaque_tid(), wave = tid >> 6, lane = tid & 63;
    float* sc = (float*)lds + wave * 256;
    const int pair = it * 8 + wave, s = pair >> 2, head = pair & 3;
    const u16* H = (const u16*)(p.ws + W_H);
    const int row = MP + s;
    const float* K = p.cache_k + ((size_t)(l * DB + s) * NM) * XW + head * 64;
    const float* V = p.cache_v + ((size_t)(l * DB + s) * NM) * XW + head * 64;
    const int lq = lane & 15, lg = lane >> 4;
    __syncthreads();
    f32x4 q4;
    {
        const u32x2 qv = *(const u32x2*)(H + (size_t)row * INW + C_Q + head * 64 + 4 * lq);
        q4.x = __uint_as_float(qv.x << 16); q4.y = __uint_as_float(qv.x & 0xffff0000u); q4.z = __uint_as_float(qv.y << 16); q4.w = __uint_as_float(qv.y & 0xffff0000u);
    }
#pragma unroll 1
    for (int i0 = 0; i0 < 64; i0 += 16) {
        f32x4 kv[16];
#pragma unroll
        for (int i = 0; i < 16; ++i) kv[i] = *(const f32x4*)(K + (size_t)(4 * (i0 + i) + lg) * XW + 4 * lq);
#pragma unroll
        for (int i = 0; i < 16; ++i) {
            float d = kv[i].x * q4.x + kv[i].y * q4.y + kv[i].z * q4.z + kv[i].w * q4.w;
            d = row16_sum(d);
            if (lq == 0) sc[4 * (i0 + i) + lg] = d * 0.125f;
        }
    }
    __syncthreads();
    float pvals[4];
    float mx = -1e30f;
#pragma unroll
    for (int i = 0; i < 4; ++i) { pvals[i] = sc[lane + 64 * i]; mx = fmaxf(mx, pvals[i]); }
    mx = wave_max(mx);
    float sum = 0.f;
#pragma unroll
    for (int i = 0; i < 4; ++i) { pvals[i] = __expf(pvals[i] - mx); sum += pvals[i]; }
    sum = wave_sum(sum);
    __syncthreads();
#pragma unroll
    for (int i = 0; i < 4; ++i) sc[lane + 64 * i] = pvals[i];
    __syncthreads();
    f32x4 acc = {0.f, 0.f, 0.f, 0.f};
#pragma unroll 1
    for (int i0 = 0; i0 < 64; i0 += 16) {
        f32x4 vv[16];
#pragma unroll
        for (int i = 0; i < 16; ++i) vv[i] = *(const f32x4*)(V + (size_t)(4 * (i0 + i) + lg) * XW + 4 * lq);
#pragma unroll
        for (int i = 0; i < 16; ++i) {
            const float pk = sc[4 * (i0 + i) + lg];
            acc.x += pk * vv[i].x; acc.y += pk * vv[i].y; acc.z += pk * vv[i].z; acc.w += pk * vv[i].w;
        }
    }
    acc.x += __shfl_xor(acc.x, 16); acc.y += __shfl_xor(acc.y, 16); acc.z += __shfl_xor(acc.z, 16); acc.w += __shfl_xor(acc.w, 16);
    acc.x += __shfl_xor(acc.x, 32); acc.y += __shfl_xor(acc.y, 32); acc.z += __shfl_xor(acc.z, 32); acc.w += __shfl_xor(acc.w, 32);
    if (lg == 0) {
        const float inv = 1.f / sum;
        const u32x2 gv = *(const u32x2*)(H + (size_t)row * INW + C_XAG + head * 64 + 4 * lq);
        const float g0 = __uint_as_float(gv.x << 16), g1 = __uint_as_float(gv.x & 0xffff0000u), g2 = __uint_as_float(gv.y << 16), g3 = __uint_as_float(gv.y & 0xffff0000u);
        u32x2 o;
        o.x = pk2(acc.x * inv * silu(g0), acc.y * inv * silu(g1));
        o.y = pk2(acc.z * inv * silu(g2), acc.w * inv * silu(g3));
        *(u32x2*)((u16*)(p.ws + W_MIX) + (size_t)row * D + 768 + head * 64 + 4 * lq) = o;
    }
}

__device__ void phaseB1(const Params& p, int l, unsigned char* lds, int bid, int nblk) {
    constexpr int N_XP = NB * XH * 16;
    constexpr int N_PREP = MT / 16;
    constexpr int N_POOL = MT / 32;
    constexpr int N_XD = DB * XH / 8;
    {
        const int tid = opaque_tid(), head = tid >> 6, lane = tid & 63;
        PrepFrags fr;
        fr.W2T = (const u16*)(p.ws + W_W2T) + ((size_t)l * RW + head * 64) * 64;
        fr.A2T = (const u16*)(p.ws + W_A2T) + ((size_t)l * RW + head * 64) * 64;
        float* cst = (float*)(lds + 8192) + head * 512;
        const int c = l * RW + head * 64 + lane;
        const float* mu = p.shift_mu + l * SW + head * 64 + lane;
        __syncthreads();
        cst[lane] = p.w0[c]; cst[64 + lane] = p.a0[c]; cst[128 + lane] = p.k_k[c]; cst[192 + lane] = p.k_a[c]; cst[256 + lane] = p.r_k[c];
        cst[320 + lane] = mu[0]; cst[384 + lane] = mu[512]; cst[448 + lane] = mu[1024];
        __syncthreads();
        unsigned* ctr = (unsigned*)(p.ws + W_BAR) + l;
        volatile int* nxt_lds = (volatile int*)(lds + LDS_BYTES + 8);
        constexpr int NTOT = N_PREP + N_XD + N_POOL + N_XP;
        int nreg = 0;
        if (tid == 0) *nxt_lds = (int)__hip_atomic_fetch_add(ctr, 1u, __ATOMIC_RELAXED, __HIP_MEMORY_SCOPE_AGENT);
        __syncthreads();
        int cur = *nxt_lds;
        while (cur < NTOT) {
            if (tid == 0) nreg = (int)__hip_atomic_fetch_add(ctr, 1u, __ATOMIC_RELAXED, __HIP_MEMORY_SCOPE_AGENT);
            int r = cur;
            if (r < N_PREP) prep_item(p, l, r, lds, fr, cst);
            else if ((r -= N_PREP) < N_XD) xattn_decode_item(p, l, r, lds);
            else if ((r -= N_XD) < N_POOL) pool_item(p, l, r, lds);
            else xattn_prompt_item(p, l, r - N_POOL, lds);
            __syncthreads();
            if (tid == 0) *nxt_lds = nreg;
            __syncthreads();
            cur = *nxt_lds;
        }
    }
}

__device__ __forceinline__ float fmul_s(float a, float b) { float d; asm("v_mul_f32 %0, %1, %2" : "=v"(d) : "v"(a), "v"(b)); return d; }
__device__ __forceinline__ float fadd_s(float a, float b) { float d; asm("v_add_f32 %0, %1, %2" : "=v"(d) : "v"(a), "v"(b)); return d; }
__device__ __forceinline__ float ffma_s(float a, float b, float c) { float d; asm("v_fma_f32 %0, %1, %2, %3" : "=v"(d) : "v"(a), "v"(b), "v"(c)); return d; }
__device__ __forceinline__ float fnma_s(float a, float b, float c) { float d; asm("v_fma_f32 %0, -%1, %2, %3" : "=v"(d) : "v"(a), "v"(b), "v"(c)); return d; }
struct StepIn { f32x4 w, kk, ka, k2; float v; };
__device__ __forceinline__ StepIn scan_load(const float* bt, int q, int vofs) {
    StepIn x;
    x.w = *(const f32x4*)(bt + 4 * q); x.kk = *(const f32x4*)(bt + 64 + 4 * q); x.ka = *(const f32x4*)(bt + 128 + 4 * q); x.k2 = *(const f32x4*)(bt + 192 + 4 * q);
    x.v = bt[vofs];
    return x;
}
constexpr int SC_CH = 16;
constexpr int SC_SUB = 8;
__device__ void phaseB2(const Params& p, int l, unsigned char* lds, int bid, int nblk) {
    const int tid = opaque_tid();
    const float* P = (const float*)(p.ws + W_P);
    float* YR = (float*)(p.ws + W_YRAW);
    for (int it = bid; it < DB * RH; it += nblk) {
        const int s = it >> 3, head = it & 7;
        const int i = tid >> 3, q = tid & 7;
        const size_t so = ((((size_t)l * DB + s) * RH + head) * 64 + i) * 64 + 8 * q;
        const float* S0 = p.state_wkv + so;
        const float* Pb = P + ((size_t)(MP + s) * RH + head) * 384;
        f32x4 sa = *(const f32x4*)S0, sb = *(const f32x4*)(S0 + 4);
        const f32x4 wa = *(const f32x4*)(Pb + 8 * q), wb = *(const f32x4*)(Pb + 8 * q + 4);
        const f32x4 ka = *(const f32x4*)(Pb + 64 + 8 * q), kb = *(const f32x4*)(Pb + 64 + 8 * q + 4);
        const f32x4 aa = *(const f32x4*)(Pb + 128 + 8 * q), ab = *(const f32x4*)(Pb + 128 + 8 * q + 4);
        const f32x4 k2a = *(const f32x4*)(Pb + 192 + 8 * q), k2b = *(const f32x4*)(Pb + 192 + 8 * q + 4);
        const f32x4 ra = *(const f32x4*)(Pb + 256 + 8 * q), rb = *(const f32x4*)(Pb + 256 + 8 * q + 4);
        const float v = Pb[320 + i];
        float d = sa.x * ka.x + sa.y * ka.y + sa.z * ka.z + sa.w * ka.w + sb.x * kb.x + sb.y * kb.y + sb.z * kb.z + sb.w * kb.w;
        float y = sa.x * ra.x + sa.y * ra.y + sa.z * ra.z + sa.w * ra.w + sb.x * rb.x + sb.y * rb.y + sb.z * rb.z + sb.w * rb.w;
        d += __shfl_xor(d, 1); d += __shfl_xor(d, 2); d += __shfl_xor(d, 4);
        y += __shfl_xor(y, 1); y += __shfl_xor(y, 2); y += __shfl_xor(y, 4);
        sa.x = sa.x * wa.x - d * aa.x + v * k2a.x; sa.y = sa.y * wa.y - d * aa.y + v * k2a.y; sa.z = sa.z * wa.z - d * aa.z + v * k2a.z; sa.w = sa.w * wa.w - d * aa.w + v * k2a.w;
        sb.x = sb.x * wb.x - d * ab.x + v * k2b.x; sb.y = sb.y * wb.y - d * ab.y + v * k2b.y; sb.z = sb.z * wb.z - d * ab.z + v * k2b.z; sb.w = sb.w * wb.w - d * ab.w + v * k2b.w;
        float* So = p.out + O_WKVS + so;
        *(f32x4*)So = sa; *(f32x4*)(So + 4) = sb;
        if (q == 0) YR[(size_t)(MP + s) * RW + head * 64 + i] = y;
    }
    float* buf = (float*)lds;
    float* ring = buf + 2 * SC_CH * 384;
    float* ybuf = ring + 2 * SC_SUB * 1024;
    const int wave = tid >> 6, lane = tid & 63;
    const bool scanner = wave < 4;
    const int lt = tid - 256;
    constexpr int NCH = T / SC_CH;
    for (int u = bid; u < NB * RH * 4; u += nblk) {
        const int bh = (u & 7) * 8 + ((u >> 3) >> 2), rg = (u >> 3) & 3;
        const int b = bh >> 3, head = bh & 7;
        const float* Pb = P + ((size_t)(b * RH + head) * T) * 384;
        __syncthreads();
        if (scanner) {
            const int rowl = wave * 4 + (lane >> 4), q = lane & 15;
            const int vofs = 320 + rg * 16 + rowl;
            float* rp = ring + (rowl * 16 + q) * 4;
            float s0 = 0.f, s1 = 0.f, s2 = 0.f, s3 = 0.f;
            __syncthreads();
            constexpr int PF = 3;
            __builtin_amdgcn_s_setprio(3);
#pragma unroll 1
            for (int c = 0; c < NCH; ++c) {
                const float* B = buf + (c & 1) * SC_CH * 384;
                StepIn in[SC_CH];
#pragma unroll
                for (int j = 0; j < PF; ++j) in[j] = scan_load(B + j * 384, q, vofs);
#pragma unroll
                for (int tt = 0; tt < SC_CH; ++tt) {
                    if (tt + PF < SC_CH) in[tt + PF] = scan_load(B + (tt + PF) * 384, q, vofs);
                    const StepIn cur = in[tt];
                    { f32x4 sv; sv.x = s0; sv.y = s1; sv.z = s2; sv.w = s3; *(f32x4*)(rp + tt * 1024) = sv; }
                    float d = fmul_s(s0, cur.kk.x); d = ffma_s(s1, cur.kk.y, d);
                    float d2 = fmul_s(s2, cur.kk.z); d2 = ffma_s(s3, cur.kk.w, d2);
                    float m0 = fmul_s(s0, cur.w.x), m1 = fmul_s(s1, cur.w.y), m2 = fmul_s(s2, cur.w.z), m3 = fmul_s(s3, cur.w.w);
                    d = fadd_s(d, d2);
                    m0 = ffma_s(cur.v, cur.k2.x, m0); m1 = ffma_s(cur.v, cur.k2.y, m1); m2 = ffma_s(cur.v, cur.k2.z, m2); m3 = ffma_s(cur.v, cur.k2.w, m3);
                    d = row16_sum(d);
                    s0 = fnma_s(d, cur.ka.x, m0); s1 = fnma_s(d, cur.ka.y, m1); s2 = fnma_s(d, cur.ka.z, m2); s3 = fnma_s(d, cur.ka.w, m3);
                    if ((tt % SC_SUB) == SC_SUB - 1) __syncthreads();
                }
            }
            __builtin_amdgcn_s_setprio(0);
            f32x4 sv; sv.x = s0; sv.y = s1; sv.z = s2; sv.w = s3;
            *(f32x4*)(p.out + O_WKVP + ((((size_t)l * NB + b) * RH + head) * 64 + rg * 16 + rowl) * 64 + 4 * q) = sv;
        } else {
            const float* gp = Pb + (size_t)(lt >> 5) * 384 + (lt & 31) * 4;
            float* lp = buf + (lt >> 5) * 384 + (lt & 31) * 4;
            f32x4 regA[6], regB[6];
            auto gload = [&](f32x4 (&r)[6], int c) {
#pragma unroll
                for (int k = 0; k < 6; ++k) r[k] = *(const f32x4*)(gp + (size_t)(c * SC_CH + 8 * (k / 3)) * 384 + (k % 3) * 128);
            };
            auto lstore = [&](const f32x4 (&r)[6], int c) {
#pragma unroll
                for (int k = 0; k < 6; ++k) *(f32x4*)(lp + (c & 1) * SC_CH * 384 + (8 * (k / 3)) * 384 + (k % 3) * 128) = r[k];
            };
            gload(regA, 0); lstore(regA, 0); gload(regB, 1); gload(regA, 2);
            __syncthreads();
            const int yrow = lt >> 4, yq = lt & 15;
            const float* yrp = ring + (yrow * 16 + yq) * 4;
            float* yg = YR + (size_t)(b * T) * RW + head * 64 + rg * 16 + yrow;
            auto ypass = [&](int pc, int ps) {
                const float* Bp = buf + (pc & 1) * SC_CH * 384 + ps * SC_SUB * 384 + 256 + 4 * yq;
                const float* rr = yrp + ps * SC_SUB * 1024;
                f32x4 sv[SC_SUB], wr[SC_SUB];
                float y[SC_SUB];
#pragma unroll
                for (int tt = 0; tt < SC_SUB; ++tt) { sv[tt] = *(const f32x4*)(rr + tt * 1024); wr[tt] = *(const f32x4*)(Bp + tt * 384); }
#pragma unroll
                for (int tt = 0; tt < SC_SUB; ++tt) y[tt] = sv[tt].x * wr[tt].x + sv[tt].y * wr[tt].y + sv[tt].z * wr[tt].z + sv[tt].w * wr[tt].w;
#pragma unroll
                for (int tt = 0; tt < SC_SUB; ++tt) y[tt] += dpp_mov<0xB1>(y[tt]);
#pragma unroll
                for (int tt = 0; tt < SC_SUB; ++tt) y[tt] += dpp_mov<0x4E>(y[tt]);
#pragma unroll
                for (int tt = 0; tt < SC_SUB; ++tt) y[tt] += dpp_mov<0x141>(y[tt]);
#pragma unroll
                for (int tt = 0; tt < SC_SUB; ++tt) y[tt] += dpp_mov<0x140>(y[tt]);
                if (yq == 0) {
#pragma unroll
                    for (int tt = 0; tt < SC_SUB; ++tt) yg[(size_t)(pc * SC_CH + ps * SC_SUB + tt) * RW] = y[tt];
                }
            };
#pragma unroll 1
            for (int c = 0; c < NCH; c += 2) {
                if (c > 0) ypass(c - 1, 1);
                asm volatile("s_waitcnt lgkmcnt(0)\n\ts_barrier" ::: "memory");
                ypass(c, 0);
                lstore(regB, c + 1);
                if (c + 3 < NCH) gload(regB, c + 3);
                asm volatile("s_waitcnt lgkmcnt(0)\n\ts_barrier" ::: "memory");
                ypass(c, 1);
                asm volatile("s_waitcnt lgkmcnt(0)\n\ts_barrier" ::: "memory");
                ypass(c + 1, 0);
                if (c + 2 < NCH) lstore(regA, c + 2);
                if (c + 4 < NCH) gload(regA, c + 4);
                asm volatile("s_waitcnt lgkmcnt(0)\n\ts_barrier" ::: "memory");
            }
            ypass(NCH - 1, 1);
        }
    }
}

__device__ void phaseB3(const Params& p, int l, unsigned char* lds, int bid, int nblk) {
    const int tid_ = opaque_tid(); const int wave = tid_ >> 6, lane = tid_ & 63;
    const float* P = (const float*)(p.ws + W_P);
    const float* YR = (const float*)(p.ws + W_YRAW);
    const float* BON = (const float*)(p.ws + W_BONUS);
    const u16* H = (const u16*)(p.ws + W_H);
    u16* MIX = (u16*)(p.ws + W_MIX);
    const int head = wave, c = head * 64 + lane;
    const float lg = p.ln_g[l * RW + c], lb = p.ln_b[l * RW + c];
    auto do_rows = [&](int row0) {
        f32x4 bv[4]; float vv[4], yy[4], gg[4];
#pragma unroll
        for (int i = 0; i < 4; ++i) {
            const int row = row0 + i;
            bv[i] = *(const f32x4*)(BON + ((size_t)row * RH + head) * 4);
            vv[i] = P[p_index(row, head) + 320 + lane];
            yy[i] = YR[(size_t)row * RW + c];
            gg[i] = bf2f(H[(size_t)row * INW + C_RWG + c]);
        }
#pragma unroll
        for (int i = 0; i < 4; ++i) {
            const int row = row0 + i;
            const float y = yy[i] + vv[i] * bv[i].z;
            const float mean = wave_sum(y) * (1.f / 64.f);
            const float dv = y - mean;
            const float var = wave_sum(dv * dv) * (1.f / 64.f);
            float yn = dv * rsqrtf(var + 64.f * 1e-5f) * lg + lb;
            yn += bv[i].x * vv[i];
            MIX[(size_t)row * D + 256 + c] = f2bf(yn * silu(gg[i]));
        }
    };
    if (nblk > 16) {
        if (bid < 8) {
#pragma unroll 1
            for (int k = 0; k < 4; ++k) do_rows(MP + bid * 16 + k * 4);
            unsigned* ctr = (unsigned*)(p.ws + W_BAR) + 8 + l;
            asm volatile("s_waitcnt vmcnt(0)" ::: "memory");
            __syncthreads();
            if (threadIdx.x == 0) {
                __builtin_amdgcn_fence(__ATOMIC_RELEASE, "agent");
                asm volatile("s_waitcnt vmcnt(0)" ::: "memory");
                __hip_atomic_fetch_add(ctr, 1u, __ATOMIC_RELAXED, __HIP_MEMORY_SCOPE_AGENT);
                unsigned sp = 0;
                while (__hip_atomic_load(ctr, __ATOMIC_RELAXED, __HIP_MEMORY_SCOPE_AGENT) < 8u && ++sp < (1u << 24)) __builtin_amdgcn_s_sleep(1);
                __builtin_amdgcn_fence(__ATOMIC_ACQUIRE, "agent");
                asm volatile("s_waitcnt vmcnt(0)" ::: "memory");
            }
            __syncthreads();
            EpiRes e{p.out, l < NL - 1 ? (u16*)(p.ws + W_XN) : nullptr, l < NL - 1 ? (float*)(p.ws + W_ROWSS) + (size_t)(l + 1) * MPAD : nullptr};
            gemm_tile((const u16*)(p.ws + W_MIX), (const u16*)(p.ws + W_WTOUT) + (size_t)l * D * D, 64 * 256, bid * 128, lds, e);
        } else {
#pragma unroll 1
            for (int row0 = (bid - 8) * 4; row0 < MP; row0 += (nblk - 8) * 4) do_rows(row0);
        }
    } else {
#pragma unroll 1
        for (int row0 = bid * 4; row0 < MT; row0 += nblk * 4) do_rows(row0);
    }
}

#define XB_TMO      128
#define XB_XCNT(j)  (256  + 64 * (j))
#define XB_XSUB(j)  (1280 + 64 * (j))
#define XB_XGEN(j)  (2304 + 64 * (j))
#define XB_TOP      3328
#define XB_TOPGEN   3392
#define XCD_BAR_WORDS 3456
#define XB_SPIN_CAP (1u << 22)
typedef volatile __attribute__((address_space(3))) unsigned* xb_lds_t;
__device__ __forceinline__ unsigned xb_ld(unsigned* p) { return __hip_atomic_load(p, __ATOMIC_RELAXED, __HIP_MEMORY_SCOPE_AGENT); }
__device__ __forceinline__ unsigned xb_add(unsigned* p, unsigned v) { return __hip_atomic_fetch_add(p, v, __ATOMIC_RELAXED, __HIP_MEMORY_SCOPE_AGENT); }
__device__ __forceinline__ unsigned xb_xcc_id() { return (unsigned)__builtin_amdgcn_s_getreg((3 << 11) | 20) & 0xFu; }
#define XB_SPIN(cond, bar) do { unsigned _sp = 0; while (cond) { __builtin_amdgcn_s_sleep(1); \
    if ((++_sp & 255u) == 0u) { if (xb_ld(&(bar)[XB_TMO])) break; if (_sp > XB_SPIN_CAP) { atomicAdd(&(bar)[XB_TMO], 1u); break; } } } } while (0)
__device__ __forceinline__ void xcd_barrier_complete(unsigned* bar, unsigned x, unsigned& nloc, unsigned& nx) {
    const unsigned G = gridDim.x;
    unsigned sum, cnt, mine, sp = 0u;
    for (;;) {
        sum = 0u; cnt = 0u; mine = 0u;
#pragma unroll
        for (unsigned j = 0; j < 16; ++j) { const unsigned c = xb_ld(&bar[XB_XCNT(j)]); sum += c; cnt += (c > 0u) ? 1u : 0u; mine = (j == x) ? c : mine; }
        if (sum == G) break;
        __builtin_amdgcn_s_sleep(1);
        if ((++sp & 255u) == 0u) { if (xb_ld(&bar[XB_TMO])) break; if (sp > XB_SPIN_CAP) { atomicAdd(&bar[XB_TMO], 1u); break; } }
    }
    nloc = mine > 0u ? mine : 1u; nx = cnt > 0u ? cnt : 1u;
}
__device__ __forceinline__ void grid_bar(unsigned* bar, unsigned x, xb_lds_t st) {
    asm volatile("s_waitcnt vmcnt(0)" ::: "memory");
    __syncthreads();
    if (threadIdx.x == 0) {
        __builtin_amdgcn_s_waitcnt(0);
        unsigned nloc = st[0], nx = st[1];
        if (nloc == 0u) { xcd_barrier_complete(bar, x, nloc, nx); st[0] = nloc; st[1] = nx; }
        const unsigned old = xb_add(&bar[XB_XSUB(x)], 1u);
        const unsigned gen = old / nloc;
        if (old + 1u == (gen + 1u) * nloc) {
            __builtin_amdgcn_fence(__ATOMIC_RELEASE, "agent");
            asm volatile("s_waitcnt vmcnt(0)" ::: "memory");
            const unsigned og = xb_add(&bar[XB_TOP], 1u);
            const unsigned tg = og / nx;
            if (og + 1u == (tg + 1u) * nx) xb_add(&bar[XB_TOPGEN], 1u);
            else XB_SPIN(xb_ld(&bar[XB_TOPGEN]) == tg, bar);
            __builtin_amdgcn_fence(__ATOMIC_ACQUIRE, "agent");
            xb_add(&bar[XB_XGEN(x)], 1u);
            asm volatile("s_waitcnt vmcnt(0)" ::: "memory");
        } else {
            XB_SPIN(xb_ld(&bar[XB_XGEN(x)]) == gen, bar);
            __builtin_amdgcn_fence(__ATOMIC_ACQUIRE, "agent");
            asm volatile("s_waitcnt vmcnt(0)" ::: "memory");
        }
    }
    __syncthreads();
}

constexpr int NPHASE = 2 + 5 * NL;
__global__ void __launch_bounds__(NTHREADS) mega(Params p) {
    extern __shared__ __attribute__((aligned(16))) unsigned char lds[];
    const int bid = blockIdx.x, nblk = gridDim.x;
    unsigned* bar = (unsigned*)(p.ws + W_BAR);
    xb_lds_t st = (xb_lds_t)(lds + LDS_BYTES);
    const unsigned xcc = xb_xcc_id();
    if (threadIdx.x == 0) { st[0] = 0u; st[1] = 0u; (void)xb_add(&bar[XB_XCNT(xcc)], 1u); }
    __syncthreads();
    for (int ph = p.ph_lo; ph < p.ph_hi; ++ph) {
        if (ph > p.ph_lo) {
            if (p.ph_hi < 0) cg::this_grid().sync();
            grid_bar(bar, xcc, st);
        }
        if (ph == 0) { phase0(p, lds, bid, nblk); continue; }
        if (ph == NPHASE - 1) { phaseN(p, NL - 1, bid, nblk); continue; }
        const int l = (ph - 1) / 5, sub = (ph - 1) % 5;
        const int reps = ((DUPMASK >> sub) & 1) ? 2 : 1;
        for (int rep = 0; rep < reps; ++rep) {
            if (rep) grid_bar(bar, xcc, st);
            switch (sub) {
                case 0: phaseA(p, l, lds, bid, nblk); break;
                case 1: phaseB1(p, l, lds, bid, nblk); break;
                case 2: phaseB2(p, l, lds, bid, nblk); break;
                case 3: phaseB3(p, l, lds, bid, nblk); break;
                case 4: phaseC(p, l, lds, bid, nblk); break;
                default: phaseN(p, l, bid, nblk); break;
            }
        }
    }
}

extern "C" void kernel_launch(void* const* d_in, const int* in_sizes, int n_in, void* d_out, int out_size, void* d_ws, size_t ws_size, hipStream_t stream) {
    static int grid = 0;
    if (grid == 0) {
        int dev = 0, cus = 0;
        hipGetDevice(&dev);
        hipDeviceGetAttribute(&cus, hipDeviceAttributeMultiprocessorCount, dev);
        hipFuncSetAttribute((const void*)mega, hipFuncAttributeMaxDynamicSharedMemorySize, LDS_BYTES + 16);
        int per_cu = 0;
        hipOccupancyMaxActiveBlocksPerMultiprocessor(&per_cu, (const void*)mega, NTHREADS, LDS_BYTES + 16);
        if (per_cu < 1) per_cu = 1;
        grid = cus;
        if (ws_size < W_END) fprintf(stderr, "kernel_launch: workspace too small: %zu < %zu\n", ws_size, (size_t)W_END);
        (void)hipGetLastError();
    }
    Params p{};
    const float* const* in = (const float* const*)d_in;
    p.x_prompt = in[0]; p.x_sample = in[1]; p.mem_prompt = in[2]; p.state_pool = in[3]; p.state_shift = in[4]; p.state_wkv = in[5]; p.cache_k = in[6]; p.cache_v = in[7];
    p.norm_g = in[8]; p.w_in = in[9]; p.w_out = in[10]; p.pool_w = in[11]; p.pool_scale = in[12]; p.shift_mu = in[13]; p.w0 = in[14]; p.w_w2 = in[15]; p.a0 = in[16]; p.w_a2 = in[17];
    p.k_k = in[18]; p.k_a = in[19]; p.r_k = in[20]; p.ln_g = in[21]; p.ln_b = in[22]; p.mem_norm_g = in[23]; p.w_kv = in[24]; p.final_g = in[25];
    p.out = (float*)d_out; p.ws = (unsigned char*)d_ws;
#if MULTI_LAUNCH
    for (int ph = 0; ph < NPHASE; ++ph) {
        p.ph_lo = ph; p.ph_hi = ph + 1;
        hipLaunchKernelGGL(mega, dim3(grid), dim3(NTHREADS), LDS_BYTES + 16, stream, p);
    }
#else
    p.ph_lo = 0; p.ph_hi = NPHASE;
    (void)hipMemsetAsync((unsigned char*)d_ws + W_BAR, 0, 16384, stream);
    void* args[] = {&p};
    hipError_t e = hipLaunchCooperativeKernel((const void*)mega, dim3(grid), dim3(NTHREADS), args, LDS_BYTES + 16, stream);
    if (e != hipSuccess) fprintf(stderr, "cooperative launch failed: %s (grid %d)\n", hipGetErrorString(e), grid);
#endif
}
```

```cpp
#include <hip/hip_runtime.h>
#include <hip/hip_cooperative_groups.h>
#include <cstdio>
namespace cg = cooperative_groups;

#ifndef DUPB1
#define DUPB1 0
#endif
#ifndef DUPMASK
#define DUPMASK 0
#endif
#ifndef MULTI_LAUNCH
#define MULTI_LAUNCH 0
#endif

typedef unsigned short u16;
typedef short bf16x8 __attribute__((ext_vector_type(8)));
typedef float f32x16 __attribute__((ext_vector_type(16)));
typedef float f32x4 __attribute__((ext_vector_type(4)));
typedef float f32x2 __attribute__((ext_vector_type(2)));
typedef unsigned u32x4 __attribute__((ext_vector_type(4)));
typedef unsigned u32x2 __attribute__((ext_vector_type(2)));

constexpr int D = 1024, NB = 8, T = 2048, NL = 4, DB = 128, NM = 256;
constexpr int PW = 256, PBUF = 15, RW = 512, RH = 8, XW = 256, XH = 4;
constexpr int SW = 1664, INW = 3200;
constexpr int MP = NB * T;
constexpr int MT = MP + DB;
constexpr int MPAD = 16640;
constexpr int C_POOLV = 0, C_POOLG = 256, C_RW = 512, C_RWG = 2176, C_Q = 2688, C_XAG = 2944;
constexpr size_t O_YP = 0;
constexpr size_t O_YS = O_YP + (size_t)MP * D;
constexpr size_t O_POOLP = O_YS + (size_t)DB * D;
constexpr size_t O_SHIFTP = O_POOLP + (size_t)NL * NB * PBUF * PW;
constexpr size_t O_WKVP = O_SHIFTP + (size_t)NL * NB * SW;
constexpr size_t O_MEMK = O_WKVP + (size_t)NL * NB * RH * 64 * 64;
constexpr size_t O_MEMV = O_MEMK + (size_t)NL * NB * NM * XW;
constexpr size_t O_POOLS = O_MEMV + (size_t)NL * NB * NM * XW;
constexpr size_t O_SHIFTS = O_POOLS + (size_t)NL * DB * PBUF * PW;
constexpr size_t O_WKVS = O_SHIFTS + (size_t)NL * DB * SW;
constexpr size_t W_WTIN = 0;
constexpr size_t W_WTOUT = W_WTIN + (size_t)NL * INW * D * 2;
constexpr size_t W_WTKV = W_WTOUT + (size_t)NL * D * D * 2;
constexpr size_t W_XN = W_WTKV + (size_t)NL * 512 * D * 2;
constexpr size_t W_MIX = W_XN + (size_t)MPAD * D * 2;
constexpr size_t W_MEMN = W_MIX + (size_t)MPAD * D * 2;
constexpr size_t W_H = W_MEMN + (size_t)NB * NM * D * 2;
constexpr size_t W_P = W_H + (size_t)MPAD * INW * 2;
constexpr size_t W_BONUS = W_P + (size_t)MT * RH * 384 * 4;
constexpr size_t W_YRAW = W_BONUS + (size_t)MT * RH * 16;
constexpr size_t W_KB = W_YRAW + (size_t)MT * RW * 4;
constexpr size_t W_VTB = W_KB + (size_t)NL * NB * NM * XW * 2;
constexpr size_t W_W2T = W_VTB + (size_t)NL * NB * NM * XW * 2;
constexpr size_t W_A2T = W_W2T + (size_t)NL * RW * 64 * 2;
constexpr size_t W_PWT = W_A2T + (size_t)NL * RW * 64 * 2;
constexpr size_t W_ROWSS = W_PWT + (size_t)NL * 4 * 64 * 64 * 2;
constexpr size_t W_BAR = W_ROWSS + (size_t)NL * MPAD * 4;
constexpr size_t W_END = W_BAR + 16384;

constexpr int LDS_BYTES = 147456;
static_assert((2 * 16 * 384 + 2 * 8 * 1024) * 4 <= LDS_BYTES, "scan LDS");
constexpr int NTHREADS = 512;

struct Params {
    const float *x_prompt, *x_sample, *mem_prompt, *state_pool, *state_shift, *state_wkv, *cache_k, *cache_v;
    const float *norm_g, *w_in, *w_out, *pool_w, *pool_scale, *shift_mu, *w0, *w_w2, *a0, *w_a2, *k_k, *k_a, *r_k, *ln_g, *ln_b, *mem_norm_g, *w_kv, *final_g;
    float* out;
    unsigned char* ws;
    int ph_lo, ph_hi;
};

#define LDS_BARRIER() do { asm volatile("s_waitcnt lgkmcnt(0)" ::: "memory"); __builtin_amdgcn_s_barrier(); asm volatile("" ::: "memory"); } while (0)
__device__ __forceinline__ int opaque_tid() { int t = threadIdx.x; asm volatile("" : "+v"(t)); return t; }
__device__ __forceinline__ u16 f2bf(float f) {
    unsigned u = __float_as_uint(f);
    u += 0x7fffu + ((u >> 16) & 1u);
    return (u16)(u >> 16);
}
__device__ __forceinline__ float bf2f(u16 h) { return __uint_as_float((unsigned)h << 16); }
__device__ __forceinline__ unsigned pk2(float a, float b) { unsigned r; asm("v_cvt_pk_bf16_f32 %0, %1, %2" : "=v"(r) : "v"(a), "v"(b)); return r; }
__device__ __forceinline__ float wave_max(float v) {
#pragma unroll
    for (int o = 1; o < 64; o <<= 1) v = fmaxf(v, __shfl_xor(v, o));
    return v;
}
__device__ __forceinline__ float silu(float x) { return x * __builtin_amdgcn_rcpf(1.f + __expf(-x)); }
template <int CTRL>
__device__ __forceinline__ float dpp_mov(float x) {
    return __int_as_float(__builtin_amdgcn_update_dpp(0, __float_as_int(x), CTRL, 0xf, 0xf, false));
}
__device__ __forceinline__ float row16_sum(float x) {
    x += dpp_mov<0xB1>(x);
    x += dpp_mov<0x4E>(x);
    x += dpp_mov<0x141>(x);
    x += dpp_mov<0x140>(x);
    return x;
}
__device__ __forceinline__ float wave_sum(float v) {
    v = row16_sum(v);
    v += __int_as_float(__builtin_amdgcn_update_dpp(0, __float_as_int(v), 0x142, 0xa, 0xf, false));
    v += __int_as_float(__builtin_amdgcn_update_dpp(0, __float_as_int(v), 0x143, 0xc, 0xf, false));
    return __int_as_float(__builtin_amdgcn_readlane(__float_as_int(v), 63));
}

__device__ __forceinline__ void norm_row(const float* src, float* xcopy, u16* dst, const float* gain_out, float* yout, int lane, float* ss_out = nullptr) {
    f32x4 v[4];
    float ss = 0.f;
#pragma unroll
    for (int j = 0; j < 4; ++j) {
        v[j] = *(const f32x4*)(src + (lane + 64 * j) * 4);
        ss += v[j].x * v[j].x + v[j].y * v[j].y + v[j].z * v[j].z + v[j].w * v[j].w;
    }
    ss = wave_sum(ss);
    const float rstd = ss_out ? 1.f : rsqrtf(ss * (1.f / D) + 1e-6f);
    if (ss_out && lane == 0) *ss_out = ss;
#pragma unroll
    for (int j = 0; j < 4; ++j) {
        const int o = (lane + 64 * j) * 4;
        if (xcopy) *(f32x4*)(xcopy + o) = v[j];
        if (dst) {
            u32x2 w;
            w.x = pk2(v[j].x * rstd, v[j].y * rstd);
            w.y = pk2(v[j].z * rstd, v[j].w * rstd);
            *(u32x2*)(dst + o) = w;
        }
        if (yout) {
            const f32x4 g = *(const f32x4*)(gain_out + o);
            f32x4 y;
            y.x = v[j].x * rstd * g.x; y.y = v[j].y * rstd * g.y; y.z = v[j].z * rstd * g.z; y.w = v[j].w * rstd * g.w;
            *(f32x4*)(yout + o) = y;
        }
    }
}

__device__ void phase0(const Params& p, unsigned char* lds, int bid, int nblk) {
    float* tile = (float*)lds;
    const int tid = opaque_tid();
    constexpr int IT_IN = 16 * 50, IT_OUT = 16 * 16, IT_KV = 16 * 8, IT_L = IT_IN + IT_OUT + IT_KV;
    struct TItem { const float* src; const float* g; u16* dst; int N, k0, n0; };
    auto item = [&](int it) {
        TItem t;
        const int l = it / IT_L;
        int r = it % IT_L;
        if (r < IT_IN) { t.src = p.w_in + (size_t)l * D * INW; t.g = p.norm_g + l * D; t.dst = (u16*)(p.ws + W_WTIN) + (size_t)l * INW * D; t.N = INW; }
        else if (r < IT_IN + IT_OUT) { r -= IT_IN; t.src = p.w_out + (size_t)l * D * D; t.g = nullptr; t.dst = (u16*)(p.ws + W_WTOUT) + (size_t)l * D * D; t.N = D; }
        else { r -= IT_IN + IT_OUT; t.src = p.w_kv + (size_t)l * D * 512; t.g = p.mem_norm_g + l * D; t.dst = (u16*)(p.ws + W_WTKV) + (size_t)l * 512 * D; t.N = 512; }
        const int nt = t.N / 64, kb = r / nt, nb = r % nt;
        t.k0 = kb * 64; t.n0 = nb * 64;
        return t;
    };
    const int tk = tid >> 4, tn4 = (tid & 15) * 4;
    f32x4 v[2]; float gg[2];
    auto tload = [&](const TItem& t) {
#pragma unroll
        for (int i = 0; i < 2; ++i) {
            const int k = tk + 32 * i;
            v[i] = *(const f32x4*)(t.src + (size_t)(t.k0 + k) * t.N + t.n0 + tn4);
            gg[i] = t.g ? t.g[t.k0 + k] : 1.f;
        }
    };
    if (bid < NL * IT_L) tload(item(bid));
#pragma unroll 1
    for (int it = bid; it < NL * IT_L; it += nblk) {
        const TItem t = item(it);
#pragma unroll
        for (int i = 0; i < 2; ++i) {
            const int k = tk + 32 * i;
            tile[k * 65 + tn4 + 0] = v[i].x * gg[i]; tile[k * 65 + tn4 + 1] = v[i].y * gg[i]; tile[k * 65 + tn4 + 2] = v[i].z * gg[i]; tile[k * 65 + tn4 + 3] = v[i].w * gg[i];
        }
        if (it + nblk < NL * IT_L) tload(item(it + nblk));
        LDS_BARRIER();
        {
            const int n = tid >> 3, kc = tid & 7;
            const float* s_ = tile + (kc * 8) * 65 + n;
            u32x4 o;
            o.x = pk2(s_[0 * 65], s_[1 * 65]); o.y = pk2(s_[2 * 65], s_[3 * 65]); o.z = pk2(s_[4 * 65], s_[5 * 65]); o.w = pk2(s_[6 * 65], s_[7 * 65]);
            *(u32x4*)(t.dst + (size_t)(t.n0 + n) * D + t.k0 + kc * 8) = o;
        }
        LDS_BARRIER();
    }
    const int wave = tid >> 6, lane = tid & 63;
    for (int row = bid * 8 + wave; row < MT + NB * NM; row += nblk * 8) {
        if (row < MT) {
            const float* src = row < MP ? p.x_prompt + (size_t)row * D : p.x_sample + (size_t)(row - MP) * D;
            norm_row(src, p.out + (size_t)row * D, (u16*)(p.ws + W_XN) + (size_t)row * D, nullptr, nullptr, lane, (float*)(p.ws + W_ROWSS) + row);
        } else {
            const int mr = row - MT;
            norm_row(p.mem_prompt + (size_t)mr * D, nullptr, (u16*)(p.ws + W_MEMN) + (size_t)mr * D, nullptr, nullptr, lane);
        }
    }
    for (int idx = bid * NTHREADS + tid; idx < (NL - 1) * MPAD; idx += nblk * NTHREADS) ((float*)(p.ws + W_ROWSS))[MPAD + idx] = 0.f;
    for (int idx = bid * NTHREADS + tid; idx < NL * 4 * 64 * 8; idx += nblk * NTHREADS) {
        const int lg_ = idx >> 9, e = (idx >> 3) & 63, kc = idx & 7;
        const float* src = p.pool_w + ((size_t)lg_ * 64 + kc * 8) * 64 + e;
        u32x4 o;
        o.x = pk2(src[0], src[64]); o.y = pk2(src[128], src[192]); o.z = pk2(src[256], src[320]); o.w = pk2(src[384], src[448]);
        *(u32x4*)((u16*)(p.ws + W_PWT) + ((size_t)lg_ * 64 + e) * 64 + kc * 8) = o;
    }
    for (int idx = bid * NTHREADS + tid; idx < 2 * NL * RW * 8; idx += nblk * NTHREADS) {
        const int which = idx / (NL * RW * 8), r = idx % (NL * RW * 8);
        const int l = r / (RW * 8), n = (r / 8) % RW, kc = r % 8;
        const float* src = (which ? p.w_a2 : p.w_w2) + (size_t)l * 64 * RW + (size_t)(kc * 8) * RW + n;
        u32x4 o;
        o.x = pk2(src[0], src[RW]); o.y = pk2(src[2 * RW], src[3 * RW]); o.z = pk2(src[4 * RW], src[5 * RW]); o.w = pk2(src[6 * RW], src[7 * RW]);
        *(u32x4*)((u16*)(p.ws + (which ? W_A2T : W_W2T)) + ((size_t)l * RW + n) * 64 + kc * 8) = o;
    }
}

constexpr int G_STAGE = 49152, G_AB = 32768;
#define RAW_BARRIER() do { asm volatile("s_waitcnt lgkmcnt(0)" ::: "memory"); __builtin_amdgcn_s_barrier(); asm volatile("" ::: "memory"); } while (0)
template <class Epi>
__device__ __forceinline__ void gemm_tile(const u16* __restrict__ A, const u16* __restrict__ Bt, int m0, int n0, unsigned char* lds, const Epi& epi) {
    const int tid = opaque_tid(), wave = tid >> 6, lane = tid & 63;
    const int wm = wave >> 1, wn = wave & 1;
    const int lr = lane & 31, lh = lane >> 5;
    f32x16 acc[2][2];
#pragma unroll
    for (int i = 0; i < 2; ++i)
#pragma unroll
        for (int j = 0; j < 2; ++j)
#pragma unroll
            for (int e = 0; e < 16; ++e) acc[i][j][e] = 0.f;
    const int lrow = lane >> 3, cpos = lane & 7;
    const u16* ga[4]; const u16* gb[2];
#pragma unroll
    for (int i = 0; i < 4; ++i) { const int row = (wave * 4 + i) * 8 + lrow; ga[i] = A + (size_t)(m0 + row) * D + ((cpos ^ ((row >> 1) & 7)) << 3); }
#pragma unroll
    for (int i = 0; i < 2; ++i) { const int row = (wave * 2 + i) * 8 + lrow; gb[i] = Bt + (size_t)(n0 + row) * D + ((cpos ^ ((row >> 1) & 7)) << 3); }
    auto glds = [&](int kt, int st) {
#pragma unroll
        for (int i = 0; i < 4; ++i) __builtin_amdgcn_global_load_lds((const unsigned*)(ga[i] + kt * 64), (__attribute__((address_space(3))) unsigned*)(lds + st * G_STAGE + (wave * 4 + i) * 1024), 16, 0, 0);
#pragma unroll
        for (int i = 0; i < 2; ++i) __builtin_amdgcn_global_load_lds((const unsigned*)(gb[i] + kt * 64), (__attribute__((address_space(3))) unsigned*)(lds + st * G_STAGE + G_AB + (wave * 2 + i) * 1024), 16, 0, 0);
    };
    int aoff[2], asw[2], boff[2], bsw[2];
#pragma unroll
    for (int i = 0; i < 2; ++i) { const int row = wm * 64 + i * 32 + lr; aoff[i] = row * 128; asw[i] = (row >> 1) & 7; }
#pragma unroll
    for (int j = 0; j < 2; ++j) { const int row = wn * 64 + j * 32 + lr; boff[j] = G_AB + row * 128; bsw[j] = (row >> 1) & 7; }
    asm volatile("s_waitcnt vmcnt(0)" ::: "memory");
    RAW_BARRIER();
    glds(0, 0); glds(1, 1);
    for (int kt = 0; kt < 16; ++kt) {
        if (kt + 1 < 16) asm volatile("s_waitcnt vmcnt(6)" ::: "memory"); else asm volatile("s_waitcnt vmcnt(0)" ::: "memory");
        RAW_BARRIER();
        if (kt + 2 < 16) glds(kt + 2, (kt + 2) % 3);
        const unsigned char* sb = lds + (kt % 3) * G_STAGE;
        bf16x8 af[2][2], bfr[2][2];
#pragma unroll
        for (int i = 0; i < 2; ++i) af[0][i] = *(const bf16x8*)(sb + aoff[i] + (((lh) ^ asw[i]) << 4));
#pragma unroll
        for (int j = 0; j < 2; ++j) bfr[0][j] = *(const bf16x8*)(sb + boff[j] + (((lh) ^ bsw[j]) << 4));
#pragma unroll
        for (int ks = 0; ks < 4; ++ks) {
            if (ks + 1 < 4) {
#pragma unroll
                for (int i = 0; i < 2; ++i) af[(ks + 1) & 1][i] = *(const bf16x8*)(sb + aoff[i] + (((2 * (ks + 1) + lh) ^ asw[i]) << 4));
#pragma unroll
                for (int j = 0; j < 2; ++j) bfr[(ks + 1) & 1][j] = *(const bf16x8*)(sb + boff[j] + (((2 * (ks + 1) + lh) ^ bsw[j]) << 4));
            }
#pragma unroll
            for (int i = 0; i < 2; ++i)
#pragma unroll
                for (int j = 0; j < 2; ++j) acc[i][j] = __builtin_amdgcn_mfma_f32_32x32x16_bf16(bfr[ks & 1][j], af[ks & 1][i], acc[i][j], 0, 0, 0);
        }
    }
    if constexpr (Epi::MODE == 0) {
#pragma unroll
        for (int i = 0; i < 2; ++i) {
            const int m = m0 + wm * 64 + i * 32 + lr;
#pragma unroll
            for (int j = 0; j < 2; ++j)
#pragma unroll
                for (int g = 0; g < 4; ++g) {
                    const int n = n0 + wn * 64 + j * 32 + 8 * g + 4 * lh;
                    f32x4 v;
                    v.x = acc[i][j][4 * g + 0]; v.y = acc[i][j][4 * g + 1]; v.z = acc[i][j][4 * g + 2]; v.w = acc[i][j][4 * g + 3];
                    epi(m, n, v);
                }
        }
    } else if constexpr (Epi::MODE == 1) {
        RAW_BARRIER();
        u16* Cs = (u16*)lds;
#pragma unroll
        for (int i = 0; i < 2; ++i) {
            const int row = wm * 64 + i * 32 + lr;
            const float rs = epi.row_scale(m0 + row);
#pragma unroll
            for (int j = 0; j < 2; ++j)
#pragma unroll
                for (int g = 0; g < 4; ++g) {
                    const int col = wn * 64 + j * 32 + 8 * g + 4 * lh;
                    u32x2 w; w.x = pk2(acc[i][j][4 * g + 0] * rs, acc[i][j][4 * g + 1] * rs); w.y = pk2(acc[i][j][4 * g + 2] * rs, acc[i][j][4 * g + 3] * rs);
                    *(u32x2*)(Cs + row * 136 + col) = w;
                }
        }
        RAW_BARRIER();
#pragma unroll
        for (int k = 0; k < 8; ++k) {
            const int id = tid + 512 * k, row = id >> 4, ch = id & 15;
            const u32x4 v = *(const u32x4*)(Cs + row * 136 + ch * 8);
            epi.store_row16(m0 + row, n0 + ch * 8, v);
        }
    } else {
        RAW_BARRIER();
        float* Cs = (float*)lds;
#pragma unroll
        for (int i = 0; i < 2; ++i) {
            const int row = wm * 64 + i * 32 + lr;
#pragma unroll
            for (int j = 0; j < 2; ++j)
#pragma unroll
                for (int g = 0; g < 4; ++g) {
                    const int col = wn * 64 + j * 32 + 8 * g + 4 * lh;
                    f32x4 v;
                    v.x = acc[i][j][4 * g + 0]; v.y = acc[i][j][4 * g + 1]; v.z = acc[i][j][4 * g + 2]; v.w = acc[i][j][4 * g + 3];
                    *(f32x4*)(Cs + row * 132 + col) = v;
                }
        }
        RAW_BARRIER();
#pragma unroll 4
        for (int k = 0; k < 16; ++k) {
            const int id = tid + 512 * k, row = id >> 5, ch = id & 31;
            const f32x4 v = *(const f32x4*)(Cs + row * 132 + ch * 4);
            epi.add_row16(m0 + row, n0 + ch * 4, v, ch);
        }
    }
}

struct EpiH {
    static constexpr int MODE = 1;
    u16* h; const float* rowss;
    __device__ __forceinline__ float row_scale(int m) const { return m < MT ? rsqrtf(rowss[m] * (1.f / D) + 1e-6f) : 0.f; }
    __device__ __forceinline__ void store_row16(int m, int n, u32x4 v) const { if (m < MT) *(u32x4*)(h + (size_t)m * INW + n) = v; }
};
struct EpiKV {
    float* mk; float* mv; u16* kb; u16* vtb;
    static constexpr int MODE = 0;
    __device__ __forceinline__ void operator()(int m, int n, f32x4 v) const {
        float* dst = n < XW ? mk + (size_t)m * XW + n : mv + (size_t)m * XW + (n - XW);
        *(f32x4*)dst = v;
        const int b = m >> 8, mm = m & 255;
        if (n < XW) {
            const int head = n >> 6, d = n & 63;
            u32x2 w; w.x = pk2(v.x, v.y); w.y = pk2(v.z, v.w);
            *(u32x2*)(kb + ((size_t)(b * XH + head) * NM + mm) * 64 + d) = w;
        } else {
            const int n2 = n - XW, head = n2 >> 6, d = n2 & 63;
            u16* q = vtb + ((size_t)(b * XH + head) * 64 + d) * NM + mm;
            q[0] = f2bf(v.x); q[NM] = f2bf(v.y); q[2 * NM] = f2bf(v.z); q[3 * NM] = f2bf(v.w);
        }
    }
};
struct EpiRes {
    static constexpr int MODE = 2;
    float* x; u16* xb; float* rowss;
    __device__ __forceinline__ void add_row16(int m, int n, f32x4 v, int ch) const {
        float s = 0.f;
        if (m < MT) {
            f32x4* q = (f32x4*)(x + (size_t)m * D + n); f32x4 o = *q; o.x += v.x; o.y += v.y; o.z += v.z; o.w += v.w; *q = o;
            if (xb) { u32x2 w; w.x = pk2(o.x, o.y); w.y = pk2(o.z, o.w); *(u32x2*)(xb + (size_t)m * D + n) = w; s = o.x * o.x + o.y * o.y + o.z * o.z + o.w * o.w; }
        }
        if (rowss) {
            s = row16_sum(s);
            s += __int_as_float(__builtin_amdgcn_update_dpp(0, __float_as_int(s), 0x142, 0xa, 0xf, false));
            if (ch == 31 && m < MT) atomicAdd(rowss + m, s);
        }
    }
};

__device__ void phaseA(const Params& p, int l, unsigned char* lds, int bid, int nblk) {
    if ((nblk & 7) == 0) {
        const int per = nblk >> 3, xcd = bid / per, j = bid % per;
        const int n_extra = xcd < 7 ? 8 : 9;
        const int n_main = 195 + n_extra;
        const int n_kv = l == 0 ? 16 : 0;
        for (int li = j; li < n_main + n_kv; li += per) {
            if (li < n_main) {
                int mt, nt;
                if (li < 195) { mt = li / 3; nt = xcd + 8 * (li % 3); } else { mt = 8 * xcd + (li - 195); nt = 24; }
                EpiH e{(u16*)(p.ws + W_H), (const float*)(p.ws + W_ROWSS) + (size_t)l * MPAD};
                gemm_tile((const u16*)(p.ws + W_XN), (const u16*)(p.ws + W_WTIN) + (size_t)l * INW * D, mt * 256, nt * 128, lds, e);
            } else {
                const int r = (li - n_main) * 8 + xcd, ll = r / 32, mt = (r % 32) / 4, nt = r % 4;
                EpiKV e{p.out + O_MEMK + (size_t)ll * NB * NM * XW, p.out + O_MEMV + (size_t)ll * NB * NM * XW, (u16*)(p.ws + W_KB) + (size_t)ll * NB * NM * XW, (u16*)(p.ws + W_VTB) + (size_t)ll * NB * NM * XW};
                gemm_tile((const u16*)(p.ws + W_MEMN), (const u16*)(p.ws + W_WTKV) + (size_t)ll * 512 * D, mt * 256, nt * 128, lds, e);
            }
        }
        return;
    }
    constexpr int NT_IN = 65 * 25;
    const int nitems = NT_IN + (l == 0 ? NL * 8 * 4 : 0);
    for (int it = bid; it < nitems; it += nblk) {
        if (it < NT_IN) {
            const int mt = it / 25, nt = it % 25;
            EpiH e{(u16*)(p.ws + W_H), (const float*)(p.ws + W_ROWSS) + (size_t)l * MPAD};
            gemm_tile((const u16*)(p.ws + W_XN), (const u16*)(p.ws + W_WTIN) + (size_t)l * INW * D, mt * 256, nt * 128, lds, e);
        } else {
            const int r = it - NT_IN, ll = r / 32, mt = (r % 32) / 4, nt = r % 4;
            EpiKV e{p.out + O_MEMK + (size_t)ll * NB * NM * XW, p.out + O_MEMV + (size_t)ll * NB * NM * XW, (u16*)(p.ws + W_KB) + (size_t)ll * NB * NM * XW, (u16*)(p.ws + W_VTB) + (size_t)ll * NB * NM * XW};
            gemm_tile((const u16*)(p.ws + W_MEMN), (const u16*)(p.ws + W_WTKV) + (size_t)ll * 512 * D, mt * 256, nt * 128, lds, e);
        }
    }
}
__device__ void phaseC(const Params& p, int l, unsigned char* lds, int bid, int nblk) {
    EpiRes e{p.out, l < NL - 1 ? (u16*)(p.ws + W_XN) : nullptr, l < NL - 1 ? (float*)(p.ws + W_ROWSS) + (size_t)(l + 1) * MPAD : nullptr};
    if ((nblk & 7) == 0 && nblk > 16) {
        const int per = nblk >> 3, xcd = bid / per, j = bid % per;
        for (int mt = j; mt < 64; mt += per) gemm_tile((const u16*)(p.ws + W_MIX), (const u16*)(p.ws + W_WTOUT) + (size_t)l * D * D, mt * 256, xcd * 128, lds, e);
        return;
    }
    for (int it = bid; it < (nblk > 16 ? 64 : 65) * 8; it += nblk) {
        const int mt = it / 8, nt = it % 8;
        gemm_tile((const u16*)(p.ws + W_MIX), (const u16*)(p.ws + W_WTOUT) + (size_t)l * D * D, mt * 256, nt * 128, lds, e);
    }
}
__device__ void phaseN(const Params& p, int l, int bid, int nblk) {
    const int tid_ = opaque_tid(); const int wave = tid_ >> 6, lane = tid_ & 63;
    for (int row = bid * 8 + wave; row < MT; row += nblk * 8) {
        float* xr = p.out + (size_t)row * D;
        if (l < NL - 1) norm_row(xr, nullptr, (u16*)(p.ws + W_XN) + (size_t)row * D, nullptr, nullptr, lane);
        else norm_row(xr, nullptr, nullptr, p.final_g, xr, lane);
    }
}

__device__ __forceinline__ size_t p_index(int row, int head) {
    return row < MP ? ((size_t)((row >> 11) * RH + head) * T + (row & (T - 1))) * 384 : ((size_t)row * RH + head) * 384;
}
__device__ __forceinline__ f32x4 bf4(u32x2 v) {
    f32x4 o; o.x = __uint_as_float(v.x << 16); o.y = __uint_as_float(v.x & 0xffff0000u); o.z = __uint_as_float(v.y << 16); o.w = __uint_as_float(v.y & 0xffff0000u);
    return o;
}
__device__ __forceinline__ f32x4 ld_bf4(const u16* p) {
    const u32x2 v = *(const u32x2*)p;
    f32x4 o; o.x = __uint_as_float(v.x << 16); o.y = __uint_as_float(v.x & 0xffff0000u); o.z = __uint_as_float(v.y << 16); o.w = __uint_as_float(v.y & 0xffff0000u);
    return o;
}
struct PrepFrags { const u16* W2T; const u16* A2T; };
__device__ __forceinline__ void prep_item(const Params& p, int l, int ti, unsigned char* lds, const PrepFrags& fr, const float* cst) {
    u16* twb = (u16*)lds;
    u16* adb = twb + 16 * 72;
    const int tid = opaque_tid(), head = tid >> 6, lane = tid & 63;
    const u16* H = (const u16*)(p.ws + W_H);
    const bool dec = ti >= MP / 16;
    const int r0 = dec ? MP + (ti - MP / 16) * 16 : ti * 16;
    const bool first = !dec && (r0 % T == 0);
    const float* mu = p.shift_mu + l * SW;
    const float* sshift = p.state_shift + (size_t)l * DB * SW;
    const int m = lane & 15, g = lane >> 4;
    const int row = r0 + m;
    const bool noprev = first && m == 0;
    u32x2 hc[4][3];
#pragma unroll
    for (int nt = 0; nt < 4; ++nt) {
        const u16* hp = H + (size_t)row * INW + C_RW + head * 64 + nt * 16 + 4 * g;
#pragma unroll
        for (int j = 0; j < 3; ++j) hc[nt][j] = *(const u32x2*)(hp + 512 * j);
    }
    __syncthreads();
#pragma unroll
    for (int i = 0; i < 4; ++i) {
        const int idx = tid + 512 * i, tt = idx >> 7, col = idx & 127;
        const int row = r0 + tt;
        const float cur = bf2f(H[(size_t)row * INW + C_RW + 1536 + col]);
        float prev;
        if (dec) prev = sshift[(size_t)(row - MP) * SW + 1536 + col];
        else prev = (tt == 0 && first) ? 0.f : bf2f(H[(size_t)(row - 1) * INW + C_RW + 1536 + col]);
        const float val = cur + (prev - cur) * mu[1536 + col];
        if (col < 64) { const float e = __expf(2.f * val); twb[tt * 72 + col] = f2bf(1.f - 2.f / (e + 1.f)); }
        else adb[tt * 72 + col - 64] = f2bf(val);
    }
    __syncthreads();
    bf16x8 btw[2], bad[2];
#pragma unroll
    for (int ks = 0; ks < 2; ++ks) { btw[ks] = *(const bf16x8*)(twb + m * 72 + ks * 32 + 8 * g); bad[ks] = *(const bf16x8*)(adb + m * 72 + ks * 32 + 8 * g); }
    float* Pp = (float*)(p.ws + W_P) + p_index(row, head);
    f32x4 kkv[4], av[4], wrv[4];
    float ss = 0.f, sbon = 0.f, sc1 = 0.f, sc2 = 0.f;
#pragma unroll
    for (int nt = 0; nt < 4; ++nt) {
        const int cl = nt * 16 + 4 * g;
        const int c = head * 64 + cl;
        f32x4 accw = {0.f, 0.f, 0.f, 0.f}, acca = {0.f, 0.f, 0.f, 0.f};
#pragma unroll
        for (int ks = 0; ks < 2; ++ks) {
            const bf16x8 aw = *(const bf16x8*)(fr.W2T + (size_t)(nt * 16 + m) * 64 + ks * 32 + 8 * g);
            const bf16x8 aa = *(const bf16x8*)(fr.A2T + (size_t)(nt * 16 + m) * 64 + ks * 32 + 8 * g);
            accw = __builtin_amdgcn_mfma_f32_16x16x32_bf16(aw, btw[ks], accw, 0, 0, 0);
            acca = __builtin_amdgcn_mfma_f32_16x16x32_bf16(aa, bad[ks], acca, 0, 0, 0);
        }
        const f32x4 w0v = *(const f32x4*)(cst + cl), a0v = *(const f32x4*)(cst + 64 + cl);
        const f32x4 kkc = *(const f32x4*)(cst + 128 + cl), kac = *(const f32x4*)(cst + 192 + cl), rkc = *(const f32x4*)(cst + 256 + cl);
        const f32x4 mr = *(const f32x4*)(cst + 320 + cl), mk = *(const f32x4*)(cst + 384 + cl), mv = *(const f32x4*)(cst + 448 + cl);
        const f32x4 cr = bf4(hc[nt][0]), ck = bf4(hc[nt][1]), cv = bf4(hc[nt][2]);
        f32x4 pr, pk, pv;
        if (dec) { const float* sp = sshift + (size_t)(row - MP) * SW + c; pr = *(const f32x4*)sp; pk = *(const f32x4*)(sp + 512); pv = *(const f32x4*)(sp + 1024); }
        else if (noprev) { pr = (f32x4){0.f, 0.f, 0.f, 0.f}; pk = pr; pv = pr; }
        else { const u16* hq = H + (size_t)(row - 1) * INW + C_RW + c; pr = ld_bf4(hq); pk = ld_bf4(hq + 512); pv = ld_bf4(hq + 1024); }
        f32x4 o_dec, o_k2, o_wr, o_v;
#pragma unroll
        for (int i = 0; i < 4; ++i) {
            const float rr = cr[i] + (pr[i] - cr[i]) * mr[i], kq = ck[i] + (pk[i] - ck[i]) * mk[i], vv = cv[i] + (pv[i] - cv[i]) * mv[i];
            const float z = -(accw[i] + w0v[i]);
            const float sp_ = fmaxf(z, 0.f) + __logf(1.f + __expf(-fabsf(z)));
            const float decay = __expf(-__expf(-sp_ - 0.5f));
            const float a = __builtin_amdgcn_rcpf(1.f + __expf(-(acca[i] + a0v[i])));
            const float kv_ = kq * kkc[i];
            const float k2 = kq * (1.f + (a - 1.f) * kac[i]);
            kkv[nt][i] = kv_; av[nt][i] = a;
            ss += kv_ * kv_; sbon += rr * k2 * rkc[i]; sc1 += kv_ * a * rr; sc2 += k2 * rr;
            o_dec[i] = decay; o_k2[i] = k2; o_wr[i] = decay * rr; o_v[i] = vv;
        }
        wrv[nt] = o_wr;
        __builtin_nontemporal_store(o_dec, (f32x4*)(Pp + cl)); __builtin_nontemporal_store(o_k2, (f32x4*)(Pp + 192 + cl)); __builtin_nontemporal_store(o_v, (f32x4*)(Pp + 320 + cl));
    }
    ss += __shfl_xor(ss, 16); sbon += __shfl_xor(sbon, 16); sc1 += __shfl_xor(sc1, 16); sc2 += __shfl_xor(sc2, 16);
    ss += __shfl_xor(ss, 32); sbon += __shfl_xor(sbon, 32); sc1 += __shfl_xor(sc1, 32); sc2 += __shfl_xor(sc2, 32);
    const float rn = 1.f / fmaxf(sqrtf(ss), 1e-12f);
    const float c1 = sc1 * rn;
#pragma unroll
    for (int nt = 0; nt < 4; ++nt) {
        const int cl = nt * 16 + 4 * g;
        f32x4 o_kk, o_ka;
#pragma unroll
        for (int i = 0; i < 4; ++i) { o_kk[i] = kkv[nt][i] * rn; o_ka[i] = o_kk[i] * av[nt][i]; wrv[nt][i] -= c1 * o_kk[i]; }
        __builtin_nontemporal_store(o_kk, (f32x4*)(Pp + 64 + cl)); __builtin_nontemporal_store(o_ka, (f32x4*)(Pp + 128 + cl)); __builtin_nontemporal_store(wrv[nt], (f32x4*)(Pp + 256 + cl));
    }
    if (g == 0) { f32x4 bv; bv.x = sbon; bv.y = sc1 * rn; bv.z = sc2; bv.w = 0.f; *(f32x4*)((float*)(p.ws + W_BONUS) + ((size_t)row * RH + head) * 4) = bv; }
    if (dec) {
        for (int idx = tid; idx < 16 * SW; idx += 512) {
            const int tt = idx / SW, col = idx % SW;
            const int s_ = r0 - MP + tt;
            p.out[O_SHIFTS + ((size_t)l * DB + s_) * SW + col] = bf2f(H[(size_t)(r0 + tt) * INW + C_RW + col]);
        }
    } else if ((r0 % T) == T - 16) {
        const int b = r0 / T;
        for (int col = tid; col < SW; col += 512)
            p.out[O_SHIFTP + ((size_t)l * NB + b) * SW + col] = bf2f(H[(size_t)(r0 + 15) * INW + C_RW + col]);
    }
}

__device__ void pool_item(const Params& p, int l, int ti, unsigned char* lds) {
    float* pv = (float*)lds;
    u16* pooled = (u16*)(pv + 47 * 256);
    const int tid = opaque_tid();
    const u16* H = (const u16*)(p.ws + W_H);
    const bool dec = ti >= MP / 32;
    const int r0 = dec ? MP + (ti - MP / 32) * 32 : ti * 32;
    const int col = tid & 255, half = tid >> 8;
    const int g = col >> 6, win = 2 << g;
    __syncthreads();
    if (!dec) {
        const int t0 = r0 % T;
        {
            u32x2 ld[6];
#pragma unroll
            for (int i = 0; i < 6; ++i) {
                const int idx = tid + 512 * i, rr = min(idx >> 6, 46), ch = idx & 63;
                const int t = t0 - 15 + rr;
                const int rowc = t >= 0 ? r0 - 15 + rr : r0;
                ld[i] = *(const u32x2*)(H + (size_t)rowc * INW + C_POOLV + ch * 4);
            }
#pragma unroll
            for (int i = 0; i < 6; ++i) {
                const int idx = tid + 512 * i, rr = idx >> 6, ch = idx & 63;
                const bool ok = (t0 - 15 + rr) >= 0;
                if (rr < 47) {
                    f32x4 v;
                    v.x = ok ? __uint_as_float(ld[i].x << 16) : 0.f; v.y = ok ? __uint_as_float(ld[i].x & 0xffff0000u) : 0.f;
                    v.z = ok ? __uint_as_float(ld[i].y << 16) : 0.f; v.w = ok ? __uint_as_float(ld[i].y & 0xffff0000u) : 0.f;
                    *(f32x4*)(pv + rr * 256 + ch * 4) = v;
                }
            }
        }
        __syncthreads();
        {
            const float* pc = pv + (15 + half * 16) * 256 + col;
            float sw = 0.f;
            for (int k = 1; k < win; ++k) sw += pc[-k * 256];
            const float rw_ = 1.f / (float)win;
#pragma unroll
            for (int i = 0; i < 16; ++i) {
                const int tt = half * 16 + i;
                const float cur = pc[i * 256];
                sw += cur;
                const int pos1 = t0 + tt + 1;
                const float inv = pos1 >= win ? rw_ : 1.f / (float)pos1;
                pooled[tt * 264 + col] = f2bf(sw * inv - cur);
                sw -= pc[(i - win + 1) * 256];
            }
        }
        if (t0 == T - 32) {
            const int b = r0 / T;
            for (int idx = tid; idx < 15 * 256; idx += 512)
                p.out[O_POOLP + ((size_t)l * NB + b) * PBUF * PW + idx] = pv[(32 + (idx >> 8)) * 256 + (idx & 255)];
        }
    } else {
#pragma unroll 1
        for (int i0 = 0; i0 < 16; i0 += 4) {
            float sv[4][15], cu[4];
#pragma unroll
            for (int j = 0; j < 4; ++j) {
                const int tt = half * 16 + i0 + j, s_ = r0 - MP + tt;
                const float* sp = p.state_pool + ((size_t)l * DB + s_) * PBUF * PW + col;
#pragma unroll
                for (int k = 0; k < 15; ++k) sv[j][k] = sp[(size_t)k * PW];
                cu[j] = bf2f(H[(size_t)(r0 + tt) * INW + C_POOLV + col]);
            }
#pragma unroll
            for (int j = 0; j < 4; ++j) {
                const int tt = half * 16 + i0 + j, s_ = r0 - MP + tt;
                float* op = p.out + O_POOLS + ((size_t)l * DB + s_) * PBUF * PW + col;
                float sum = cu[j];
#pragma unroll
                for (int k = 0; k < 15; ++k) {
                    if (k >= 1) op[(size_t)(k - 1) * PW] = sv[j][k];
                    sum += (k >= 16 - win) ? sv[j][k] : 0.f;
                }
                op[(size_t)14 * PW] = cu[j];
                pooled[tt * 264 + col] = f2bf(sum / (float)win - cu[j]);
            }
        }
    }
    __syncthreads();
    {
        const int wave = tid >> 6, lane = tid & 63, lr = lane & 31, lh = lane >> 5;
        const int gg = wave >> 1, nh = wave & 1;
        const u16* PWT = (const u16*)(p.ws + W_PWT) + ((size_t)(l * 4 + gg) * 64 + nh * 32 + lr) * 64 + 8 * lh;
        f32x16 acc;
#pragma unroll
        for (int e = 0; e < 16; ++e) acc[e] = 0.f;
#pragma unroll
        for (int ks = 0; ks < 4; ++ks) {
            const bf16x8 a = *(const bf16x8*)(PWT + ks * 16);
            const bf16x8 bq = *(const bf16x8*)(pooled + lr * 264 + gg * 64 + ks * 16 + 8 * lh);
            acc = __builtin_amdgcn_mfma_f32_32x32x16_bf16(a, bq, acc, 0, 0, 0);
        }
        const int row = r0 + lr;
        u16* MIX = (u16*)(p.ws + W_MIX);
#pragma unroll
        for (int q = 0; q < 4; ++q) {
            const int cc = gg * 64 + nh * 32 + 8 * q + 4 * lh;
            const f32x4 sc = *(const f32x4*)(p.pool_scale + l * PW + cc);
            const f32x4 gt = ld_bf4(H + (size_t)row * INW + C_POOLG + cc);
            u32x2 o;
            o.x = pk2(acc[4 * q + 0] * sc.x * silu(gt.x), acc[4 * q + 1] * sc.y * silu(gt.y));
            o.y = pk2(acc[4 * q + 2] * sc.z * silu(gt.z), acc[4 * q + 3] * sc.w * silu(gt.w));
            *(u32x2*)(MIX + (size_t)row * D + cc) = o;
        }
    }
}

constexpr int KLD = 72, VLD = 264;
__device__ void xattn_prompt_item(const Params& p, int l, int it, unsigned char* lds) {
    u16* Ks = (u16*)lds;
    u16* Vt = Ks + 256 * KLD;
    const int tid = opaque_tid(), wave = tid >> 6, lane = tid & 63;
    const int b = it >> 6, head = (it >> 4) & 3, qc = it & 15;
    const u16* KB = (const u16*)(p.ws + W_KB) + ((size_t)((l * NB + b) * XH + head) * NM) * 64;
    const u16* VTB = (const u16*)(p.ws + W_VTB) + ((size_t)((l * NB + b) * XH + head) * 64) * NM;
    __syncthreads();
#pragma unroll
    for (int i = 0; i < 4; ++i) {
        const int idx = tid + 512 * i;
        const int m = idx >> 3, ch = idx & 7;
        *(u32x4*)(Ks + m * KLD + ch * 8) = *(const u32x4*)(KB + m * 64 + ch * 8);
        const int d = idx >> 5, cv = idx & 31;
        *(u32x4*)(Vt + d * VLD + cv * 8) = *(const u32x4*)(VTB + d * NM + cv * 8);
    }
    __syncthreads();
    const u16* H = (const u16*)(p.ws + W_H);
    const int lq = lane & 15, lg = lane >> 4;
    const int row = b * T + qc * 128 + wave * 16 + lq;
    bf16x8 qf[2];
#pragma unroll
    for (int ks = 0; ks < 2; ++ks) qf[ks] = *(const bf16x8*)(H + (size_t)row * INW + C_Q + head * 64 + ks * 32 + 8 * lg);
    f32x4 st[16];
#pragma unroll
    for (int kt = 0; kt < 16; ++kt) {
        f32x4 acc = {0.f, 0.f, 0.f, 0.f};
#pragma unroll
        for (int ks = 0; ks < 2; ++ks) {
            const bf16x8 a = *(const bf16x8*)(Ks + (kt * 16 + lq) * KLD + ks * 32 + 8 * lg);
            acc = __builtin_amdgcn_mfma_f32_16x16x32_bf16(a, qf[ks], acc, 0, 0, 0);
        }
        st[kt] = acc;
    }
    float mx = -1e30f;
#pragma unroll
    for (int kt = 0; kt < 16; ++kt) mx = fmaxf(mx, fmaxf(fmaxf(st[kt].x, st[kt].y), fmaxf(st[kt].z, st[kt].w)));
    mx = fmaxf(mx, __shfl_xor(mx, 16)); mx = fmaxf(mx, __shfl_xor(mx, 32));
    float sum = 0.f;
#pragma unroll
    for (int kt = 0; kt < 16; ++kt) {
        st[kt].x = __expf((st[kt].x - mx) * 0.125f); st[kt].y = __expf((st[kt].y - mx) * 0.125f);
        st[kt].z = __expf((st[kt].z - mx) * 0.125f); st[kt].w = __expf((st[kt].w - mx) * 0.125f);
        sum += st[kt].x + st[kt].y + st[kt].z + st[kt].w;
    }
    sum += __shfl_xor(sum, 16); sum += __shfl_xor(sum, 32);
    const float inv = 1.f / sum;
    f32x4 ao[4];
#pragma unroll
    for (int dt = 0; dt < 4; ++dt) ao[dt] = (f32x4){0.f, 0.f, 0.f, 0.f};
#pragma unroll
    for (int m = 0; m < 8; ++m) {
        u32x4 pb;
        pb.x = pk2(st[2 * m].x, st[2 * m].y); pb.y = pk2(st[2 * m].z, st[2 * m].w);
        pb.z = pk2(st[2 * m + 1].x, st[2 * m + 1].y); pb.w = pk2(st[2 * m + 1].z, st[2 * m + 1].w);
        const bf16x8 pf = __builtin_bit_cast(bf16x8, pb);
#pragma unroll
        for (int dt = 0; dt < 4; ++dt) {
            const u16* vp = Vt + (dt * 16 + lq) * VLD + 32 * m + 4 * lg;
            u32x4 av;
            const u32x2 lo = *(const u32x2*)vp, hi = *(const u32x2*)(vp + 16);
            av.x = lo.x; av.y = lo.y; av.z = hi.x; av.w = hi.y;
            ao[dt] = __builtin_amdgcn_mfma_f32_16x16x32_bf16(__builtin_bit_cast(bf16x8, av), pf, ao[dt], 0, 0, 0);
        }
    }
    u16* MIX = (u16*)(p.ws + W_MIX);
#pragma unroll
    for (int dt = 0; dt < 4; ++dt) {
        const int d = dt * 16 + 4 * lg;
        const u32x2 gv = *(const u32x2*)(H + (size_t)row * INW + C_XAG + head * 64 + d);
        const float g0 = __uint_as_float(gv.x << 16), g1 = __uint_as_float(gv.x & 0xffff0000u), g2 = __uint_as_float(gv.y << 16), g3 = __uint_as_float(gv.y & 0xffff0000u);
        u32x2 o;
        o.x = pk2(ao[dt].x * inv * silu(g0), ao[dt].y * inv * silu(g1));
        o.y = pk2(ao[dt].z * inv * silu(g2), ao[dt].w * inv * silu(g3));
        *(u32x2*)(MIX + (size_t)row * D + 768 + head * 64 + d) = o;
    }
}

__device__ void xattn_decode_item(const Params& p, int l, int it, unsigned char* lds) {
    const int tid = opaque_tid(), wave = tid >> 6, lane = tid & 63;
    float* sc = (float*)lds + wave * 256;
    const int pair = it * 8 + wave, s = pair >> 2, head = pair & 3;
    const u16* H = (const u16*)(p.ws + W_H);
    const int row = MP + s;
    const float* K = p.cache_k + ((size_t)(l * DB + s) * NM) * XW + head * 64;
    const float* V = p.cache_v + ((size_t)(l * DB + s) * NM) * XW + head * 64;
    const int lq = lane & 15, lg = lane >> 4;
    __syncthreads();
    f32x4 q4;
    {
        const u32x2 qv = *(const u32x2*)(H + (size_t)row * INW + C_Q + head * 64 + 4 * lq);
        q4.x = __uint_as_float(qv.x << 16); q4.y = __uint_as_float(qv.x & 0xffff0000u); q4.z = __uint_as_float(qv.y << 16); q4.w = __uint_as_float(qv.y & 0xffff0000u);
    }
#pragma unroll 1
    for (int i0 = 0; i0 < 64; i0 += 16) {
        f32x4 kv[16];
#pragma unroll
        for (int i = 0; i < 16; ++i) kv[i] = *(const f32x4*)(K + (size_t)(4 * (i0 + i) + lg) * XW + 4 * lq);
#pragma unroll
        for (int i = 0; i < 16; ++i) {
            float d = kv[i].x * q4.x + kv[i].y * q4.y + kv[i].z * q4.z + kv[i].w * q4.w;
            d = row16_sum(d);
            if (lq == 0) sc[4 * (i0 + i) + lg] = d * 0.125f;
        }
    }
    __syncthreads();
    float pvals[4];
    float mx = -1e30f;
#pragma unroll
    for (int i = 0; i < 4; ++i) { pvals[i] = sc[lane + 64 * i]; mx = fmaxf(mx, pvals[i]); }
    mx = wave_max(mx);
    float sum = 0.f;
#pragma unroll
    for (int i = 0; i < 4; ++i) { pvals[i] = __expf(pvals[i] - mx); sum += pvals[i]; }
    sum = wave_sum(sum);
    __syncthreads();
#pragma unroll
    for (int i = 0; i < 4; ++i) sc[lane + 64 * i] = pvals[i];
    __syncthreads();
    f32x4 acc = {0.f, 0.f, 0.f, 0.f};
#pragma unroll 1
    for (int i0 = 0; i0 < 64; i0 += 16) {
        f32x4 vv[16];
#pragma unroll
        for (int i = 0; i < 16; ++i) vv[i] = *(const f32x4*)(V + (size_t)(4 * (i0 + i) + lg) * XW + 4 * lq);
#pragma unroll
        for (int i = 0; i < 16; ++i) {
            const float pk = sc[4 * (i0 + i) + lg];
            acc.x += pk * vv[i].x; acc.y += pk * vv[i].y; acc.z += pk * vv[i].z; acc.w += pk * vv[i].w;
        }
    }
    acc.x += __shfl_xor(acc.x, 16); acc.y += __shfl_xor(acc.y, 16); acc.z += __shfl_xor(acc.z, 16); acc.w += __shfl_xor(acc.w, 16);
    acc.x += __shfl_xor(acc.x, 32); acc.y += __shfl_xor(acc.y, 32); acc.z += __shfl_xor(acc.z, 32); acc.w += __shfl_xor(acc.w, 32);
    if (lg == 0) {
        const float inv = 1.f / sum;
        const u32x2 gv = *(const u32x2*)(H + (size_t)row * INW + C_XAG + head * 64 + 4 * lq);
        const float g0 = __uint_as_float(gv.x << 16), g1 = __uint_as_float(gv.x & 0xffff0000u), g2 = __uint_as_float(gv.y << 16), g3 = __uint_as_float(gv.y & 0xffff0000u);
        u32x2 o;
        o.x = pk2(acc.x * inv * silu(g0), acc.y * inv * silu(g1));
        o.y = pk2(acc.z * inv * silu(g2), acc.w * inv * silu(g3));
        *(u32x2*)((u16*)(p.ws + W_MIX) + (size_t)row * D + 768 + head * 64 + 4 * lq) = o;
    }
}

__device__ void phaseB1(const Params& p, int l, unsigned char* lds, int bid, int nblk) {
    constexpr int N_XP = NB * XH * 16;
    constexpr int N_PREP = MT / 16;
    constexpr int N_POOL = MT / 32;
    constexpr int N_XD = DB * XH / 8;
    {
        const int tid = opaque_tid(), head = tid >> 6, lane = tid & 63;
        PrepFrags fr;
        fr.W2T = (const u16*)(p.ws + W_W2T) + ((size_t)l * RW + head * 64) * 64;
        fr.A2T = (const u16*)(p.ws + W_A2T) + ((size_t)l * RW + head * 64) * 64;
        float* cst = (float*)(lds + 8192) + head * 512;
        const int c = l * RW + head * 64 + lane;
        const float* mu = p.shift_mu + l * SW + head * 64 + lane;
        __syncthreads();
        cst[lane] = p.w0[c]; cst[64 + lane] = p.a0[c]; cst[128 + lane] = p.k_k[c]; cst[192 + lane] = p.k_a[c]; cst[256 + lane] = p.r_k[c];
        cst[320 + lane] = mu[0]; cst[384 + lane] = mu[512]; cst[448 + lane] = mu[1024];
        __syncthreads();
        unsigned* ctr = (unsigned*)(p.ws + W_BAR) + l;
        volatile int* nxt_lds = (volatile int*)(lds + LDS_BYTES + 8);
        constexpr int NTOT = N_PREP + N_XD + N_POOL + N_XP;
        int nreg = 0;
        if (tid == 0) *nxt_lds = (int)__hip_atomic_fetch_add(ctr, 1u, __ATOMIC_RELAXED, __HIP_MEMORY_SCOPE_AGENT);
        __syncthreads();
        int cur = *nxt_lds;
        while (cur < NTOT) {
            if (tid == 0) nreg = (int)__hip_atomic_fetch_add(ctr, 1u, __ATOMIC_RELAXED, __HIP_MEMORY_SCOPE_AGENT);
            int r = cur;
            if (r < N_PREP) prep_item(p, l, r, lds, fr, cst);
            else if ((r -= N_PREP) < N_XD) xattn_decode_item(p, l, r, lds);
            else if ((r -= N_XD) < N_POOL) pool_item(p, l, r, lds);
            else xattn_prompt_item(p, l, r - N_POOL, lds);
            __syncthreads();
            if (tid == 0) *nxt_lds = nreg;
            __syncthreads();
            cur = *nxt_lds;
        }
    }
}

__device__ __forceinline__ float fmul_s(float a, float b) { float d; asm("v_mul_f32 %0, %1, %2" : "=v"(d) : "v"(a), "v"(b)); return d; }
__device__ __forceinline__ float fadd_s(float a, float b) { float d; asm("v_add_f32 %0, %1, %2" : "=v"(d) : "v"(a), "v"(b)); return d; }
__device__ __forceinline__ float ffma_s(float a, float b, float c) { float d; asm("v_fma_f32 %0, %1, %2, %3" : "=v"(d) : "v"(a), "v"(b), "v"(c)); return d; }
__device__ __forceinline__ float fnma_s(float a, float b, float c) { float d; asm("v_fma_f32 %0, -%1, %2, %3" : "=v"(d) : "v"(a), "v"(b), "v"(c)); return d; }
struct StepIn { f32x4 w, kk, ka, k2; float v; };
__device__ __forceinline__ StepIn scan_load(const float* bt, int q, int vofs) {
    StepIn x;
    x.w = *(const f32x4*)(bt + 4 * q); x.kk = *(const f32x4*)(bt + 64 + 4 * q); x.ka = *(const f32x4*)(bt + 128 + 4 * q); x.k2 = *(const f32x4*)(bt + 192 + 4 * q);
    x.v = bt[vofs];
    return x;
}
constexpr int SC_CH = 16;
constexpr int SC_SUB = 8;
__device__ void phaseB2(const Params& p, int l, unsigned char* lds, int bid, int nblk) {
    const int tid = opaque_tid();
    const float* P = (const float*)(p.ws + W_P);
    float* YR = (float*)(p.ws + W_YRAW);
    for (int it = bid; it < DB * RH; it += nblk) {
        const int s = it >> 3, head = it & 7;
        const int i = tid >> 3, q = tid & 7;
        const size_t so = ((((size_t)l * DB + s) * RH + head) * 64 + i) * 64 + 8 * q;
        const float* S0 = p.state_wkv + so;
        const float* Pb = P + ((size_t)(MP + s) * RH + head) * 384;
        f32x4 sa = *(const f32x4*)S0, sb = *(const f32x4*)(S0 + 4);
        const f32x4 wa = *(const f32x4*)(Pb + 8 * q), wb = *(const f32x4*)(Pb + 8 * q + 4);
        const f32x4 ka = *(const f32x4*)(Pb + 64 + 8 * q), kb = *(const f32x4*)(Pb + 64 + 8 * q + 4);
        const f32x4 aa = *(const f32x4*)(Pb + 128 + 8 * q), ab = *(const f32x4*)(Pb + 128 + 8 * q + 4);
        const f32x4 k2a = *(const f32x4*)(Pb + 192 + 8 * q), k2b = *(const f32x4*)(Pb + 192 + 8 * q + 4);
        const f32x4 ra = *(const f32x4*)(Pb + 256 + 8 * q), rb = *(const f32x4*)(Pb + 256 + 8 * q + 4);
        const float v = Pb[320 + i];
        float d = sa.x * ka.x + sa.y * ka.y + sa.z * ka.z + sa.w * ka.w + sb.x * kb.x + sb.y * kb.y + sb.z * kb.z + sb.w * kb.w;
        float y = sa.x * ra.x + sa.y * ra.y + sa.z * ra.z + sa.w * ra.w + sb.x * rb.x + sb.y * rb.y + sb.z * rb.z + sb.w * rb.w;
        d += __shfl_xor(d, 1); d += __shfl_xor(d, 2); d += __shfl_xor(d, 4);
        y += __shfl_xor(y, 1); y += __shfl_xor(y, 2); y += __shfl_xor(y, 4);
        sa.x = sa.x * wa.x - d * aa.x + v * k2a.x; sa.y = sa.y * wa.y - d * aa.y + v * k2a.y; sa.z = sa.z * wa.z - d * aa.z + v * k2a.z; sa.w = sa.w * wa.w - d * aa.w + v * k2a.w;
        sb.x = sb.x * wb.x - d * ab.x + v * k2b.x; sb.y = sb.y * wb.y - d * ab.y + v * k2b.y; sb.z = sb.z * wb.z - d * ab.z + v * k2b.z; sb.w = sb.w * wb.w - d * ab.w + v * k2b.w;
        float* So = p.out + O_WKVS + so;
        *(f32x4*)So = sa; *(f32x4*)(So + 4) = sb;
        if (q == 0) YR[(size_t)(MP + s) * RW + head * 64 + i] = y;
    }
    float* buf = (float*)lds;
    float* ring = buf + 2 * SC_CH * 384;
    float* ybuf = ring + 2 * SC_SUB * 1024;
    const int wave = tid >> 6, lane = tid & 63;
    const bool scanner = wave < 4;
    const int lt = tid - 256;
    constexpr int NCH = T / SC_CH;
    for (int u = bid; u < NB * RH * 4; u += nblk) {
        const int bh = (u & 7) * 8 + ((u >> 3) >> 2), rg = (u >> 3) & 3;
        const int b = bh >> 3, head = bh & 7;
        const float* Pb = P + ((size_t)(b * RH + head) * T) * 384;
        __syncthreads();
        if (scanner) {
            const int rowl = wave * 4 + (lane >> 4), q = lane & 15;
            const int vofs = 320 + rg * 16 + rowl;
            float* rp = ring + (rowl * 16 + q) * 4;
            float s0 = 0.f, s1 = 0.f, s2 = 0.f, s3 = 0.f;
            __syncthreads();
            constexpr int PF = 3;
            __builtin_amdgcn_s_setprio(3);
#pragma unroll 1
            for (int c = 0; c < NCH; ++c) {
                const float* B = buf + (c & 1) * SC_CH * 384;
                StepIn in[SC_CH];
#pragma unroll
                for (int j = 0; j < PF; ++j) in[j] = scan_load(B + j * 384, q, vofs);
#pragma unroll
                for (int tt = 0; tt < SC_CH; ++tt) {
                    if (tt + PF < SC_CH) in[tt + PF] = scan_load(B + (tt + PF) * 384, q, vofs);
                    const StepIn cur = in[tt];
                    { f32x4 sv; sv.x = s0; sv.y = s1; sv.z = s2; sv.w = s3; *(f32x4*)(rp + tt * 1024) = sv; }
                    float d = fmul_s(s0, cur.kk.x); d = ffma_s(s1, cur.kk.y, d);
                    float d2 = fmul_s(s2, cur.kk.z); d2 = ffma_s(s3, cur.kk.w, d2);
                    float m0 = fmul_s(s0, cur.w.x), m1 = fmul_s(s1, cur.w.y), m2 = fmul_s(s2, cur.w.z), m3 = fmul_s(s3, cur.w.w);
                    d = fadd_s(d, d2);
                    m0 = ffma_s(cur.v, cur.k2.x, m0); m1 = ffma_s(cur.v, cur.k2.y, m1); m2 = ffma_s(cur.v, cur.k2.z, m2); m3 = ffma_s(cur.v, cur.k2.w, m3);
                    d = row16_sum(d);
                    s0 = fnma_s(d, cur.ka.x, m0); s1 = fnma_s(d, cur.ka.y, m1); s2 = fnma_s(d, cur.ka.z, m2); s3 = fnma_s(d, cur.ka.w, m3);
                    if ((tt % SC_SUB) == SC_SUB - 1) __syncthreads();
                }
            }
            __builtin_amdgcn_s_setprio(0);
            f32x4 sv; sv.x = s0; sv.y = s1; sv.z = s2; sv.w = s3;
            *(f32x4*)(p.out + O_WKVP + ((((size_t)l * NB + b) * RH + head) * 64 + rg * 16 + rowl) * 64 + 4 * q) = sv;
        } else {
            const float* gp = Pb + (size_t)(lt >> 5) * 384 + (lt & 31) * 4;
            float* lp = buf + (lt >> 5) * 384 + (lt & 31) * 4;
            f32x4 regA[6], regB[6];
            auto gload = [&](f32x4 (&r)[6], int c) {
#pragma unroll
                for (int k = 0; k < 6; ++k) r[k] = *(const f32x4*)(gp + (size_t)(c * SC_CH + 8 * (k / 3)) * 384 + (k % 3) * 128);
            };
            auto lstore = [&](const f32x4 (&r)[6], int c) {
#pragma unroll
                for (int k = 0; k < 6; ++k) *(f32x4*)(lp + (c & 1) * SC_CH * 384 + (8 * (k / 3)) * 384 + (k % 3) * 128) = r[k];
            };
            gload(regA, 0); lstore(regA, 0); gload(regB, 1); gload(regA, 2);
            __syncthreads();
            const int yrow = lt >> 4, yq = lt & 15;
            const float* yrp = ring + (yrow * 16 + yq) * 4;
            float* yg = YR + (size_t)(b * T) * RW + head * 64 + rg * 16 + yrow;
            auto ypass = [&](int pc, int ps) {
                const float* Bp = buf + (pc & 1) * SC_CH * 384 + ps * SC_SUB * 384 + 256 + 4 * yq;
                const float* rr = yrp + ps * SC_SUB * 1024;
                f32x4 sv[SC_SUB], wr[SC_SUB];
                float y[SC_SUB];
#pragma unroll
                for (int tt = 0; tt < SC_SUB; ++tt) { sv[tt] = *(const f32x4*)(rr + tt * 1024); wr[tt] = *(const f32x4*)(Bp + tt * 384); }
#pragma unroll
                for (int tt = 0; tt < SC_SUB; ++tt) y[tt] = sv[tt].x * wr[tt].x + sv[tt].y * wr[tt].y + sv[tt].z * wr[tt].z + sv[tt].w * wr[tt].w;
#pragma unroll
                for (int tt = 0; tt < SC_SUB; ++tt) y[tt] += dpp_mov<0xB1>(y[tt]);
#pragma unroll
                for (int tt = 0; tt < SC_SUB; ++tt) y[tt] += dpp_mov<0x4E>(y[tt]);
#pragma unroll
                for (int tt = 0; tt < SC_SUB; ++tt) y[tt] += dpp_mov<0x141>(y[tt]);
#pragma unroll
                for (int tt = 0; tt < SC_SUB; ++tt) y[tt] += dpp_mov<0x140>(y[tt]);
                if (yq == 0) {
#pragma unroll
                    for (int tt = 0; tt < SC_SUB; ++tt) yg[(size_t)(pc * SC_CH + ps * SC_SUB + tt) * RW] = y[tt];
                }
            };
#pragma unroll 1
            for (int c = 0; c < NCH; c += 2) {
                if (c > 0) ypass(c - 1, 1);
                asm volatile("s_waitcnt lgkmcnt(0)\n\ts_barrier" ::: "memory");
                ypass(c, 0);
                lstore(regB, c + 1);
                if (c + 3 < NCH) gload(regB, c + 3);
                asm volatile("s_waitcnt lgkmcnt(0)\n\ts_barrier" ::: "memory");
                ypass(c, 1);
                asm volatile("s_waitcnt lgkmcnt(0)\n\ts_barrier" ::: "memory");
                ypass(c + 1, 0);
                if (c + 2 < NCH) lstore(regA, c + 2);
                if (c + 4 < NCH) gload(regA, c + 4);
                asm volatile("s_waitcnt lgkmcnt(0)\n\ts_barrier" ::: "memory");
            }
            ypass(NCH - 1, 1);
        }
    }
}

__device__ void phaseB3(const Params& p, int l, unsigned char* lds, int bid, int nblk) {
    const int tid_ = opaque_tid(); const int wave = tid_ >> 6, lane = tid_ & 63;
    const float* P = (const float*)(p.ws + W_P);
    const float* YR = (const float*)(p.ws + W_YRAW);
    const float* BON = (const float*)(p.ws + W_BONUS);
    const u16* H = (const u16*)(p.ws + W_H);
    u16* MIX = (u16*)(p.ws + W_MIX);
    const int head = wave, c = head * 64 + lane;
    const float lg = p.ln_g[l * RW + c], lb = p.ln_b[l * RW + c];
    auto do_rows = [&](int row0) {
        f32x4 bv[4]; float vv[4], yy[4], gg[4];
#pragma unroll
        for (int i = 0; i < 4; ++i) {
            const int row = row0 + i;
            bv[i] = *(const f32x4*)(BON + ((size_t)row * RH + head) * 4);
            vv[i] = P[p_index(row, head) + 320 + lane];
            yy[i] = YR[(size_t)row * RW + c];
            gg[i] = bf2f(H[(size_t)row * INW + C_RWG + c]);
        }
#pragma unroll
        for (int i = 0; i < 4; ++i) {
            const int row = row0 + i;
            const float y = yy[i] + vv[i] * bv[i].z;
            const float mean = wave_sum(y) * (1.f / 64.f);
            const float dv = y - mean;
            const float var = wave_sum(dv * dv) * (1.f / 64.f);
            float yn = dv * rsqrtf(var + 64.f * 1e-5f) * lg + lb;
            yn += bv[i].x * vv[i];
            MIX[(size_t)row * D + 256 + c] = f2bf(yn * silu(gg[i]));
        }
    };
    if (nblk > 16) {
        if (bid < 8) {
#pragma unroll 1
            for (int k = 0; k < 4; ++k) do_rows(MP + bid * 16 + k * 4);
            unsigned* ctr = (unsigned*)(p.ws + W_BAR) + 8 + l;
            asm volatile("s_waitcnt vmcnt(0)" ::: "memory");
            __syncthreads();
            if (threadIdx.x == 0) {
                __builtin_amdgcn_fence(__ATOMIC_RELEASE, "agent");
                asm volatile("s_waitcnt vmcnt(0)" ::: "memory");
                __hip_atomic_fetch_add(ctr, 1u, __ATOMIC_RELAXED, __HIP_MEMORY_SCOPE_AGENT);
                unsigned sp = 0;
                while (__hip_atomic_load(ctr, __ATOMIC_RELAXED, __HIP_MEMORY_SCOPE_AGENT) < 8u && ++sp < (1u << 24)) __builtin_amdgcn_s_sleep(1);
                __builtin_amdgcn_fence(__ATOMIC_ACQUIRE, "agent");
                asm volatile("s_waitcnt vmcnt(0)" ::: "memory");
            }
            __syncthreads();
            EpiRes e{p.out, l < NL - 1 ? (u16*)(p.ws + W_XN) : nullptr, l < NL - 1 ? (float*)(p.ws + W_ROWSS) + (size_t)(l + 1) * MPAD : nullptr};
            gemm_tile((const u16*)(p.ws + W_MIX), (const u16*)(p.ws + W_WTOUT) + (size_t)l * D * D, 64 * 256, bid * 128, lds, e);
        } else {
#pragma unroll 1
            for (int row0 = (bid - 8) * 4; row0 < MP; row0 += (nblk - 8) * 4) do_rows(row0);
        }
    } else {
#pragma unroll 1
        for (int row0 = bid * 4; row0 < MT; row0 += nblk * 4) do_rows(row0);
    }
}

#define XB_TMO      128
#define XB_XCNT(j)  (256  + 64 * (j))
#define XB_XSUB(j)  (1280 + 64 * (j))
#define XB_XGEN(j)  (2304 + 64 * (j))
#define XB_TOP      3328
#define XB_TOPGEN   3392
#define XCD_BAR_WORDS 3456
#define XB_SPIN_CAP (1u << 22)
typedef volatile __attribute__((address_space(3))) unsigned* xb_lds_t;
__device__ __forceinline__ unsigned xb_ld(unsigned* p) { return __hip_atomic_load(p, __ATOMIC_RELAXED, __HIP_MEMORY_SCOPE_AGENT); }
__device__ __forceinline__ unsigned xb_add(unsigned* p, unsigned v) { return __hip_atomic_fetch_add(p, v, __ATOMIC_RELAXED, __HIP_MEMORY_SCOPE_AGENT); }
__device__ __forceinline__ unsigned xb_xcc_id() { return (unsigned)__builtin_amdgcn_s_getreg((3 << 11) | 20) & 0xFu; }
#define XB_SPIN(cond, bar) do { unsigned _sp = 0; while (cond) { __builtin_amdgcn_s_sleep(1); \
    if ((++_sp & 255u) == 0u) { if (xb_ld(&(bar)[XB_TMO])) break; if (_sp > XB_SPIN_CAP) { atomicAdd(&(bar)[XB_TMO], 1u); break; } } } } while (0)
__device__ __forceinline__ void xcd_barrier_complete(unsigned* bar, unsigned x, unsigned& nloc, unsigned& nx) {
    const unsigned G = gridDim.x;
    unsigned sum, cnt, mine, sp = 0u;
    for (;;) {
        sum = 0u; cnt = 0u; mine = 0u;
#pragma unroll
        for (unsigned j = 0; j < 16; ++j) { const unsigned c = xb_ld(&bar[XB_XCNT(j)]); sum += c; cnt += (c > 0u) ? 1u : 0u; mine = (j == x) ? c : mine; }
        if (sum == G) break;
        __builtin_amdgcn_s_sleep(1);
        if ((++sp & 255u) == 0u) { if (xb_ld(&bar[XB_TMO])) break; if (sp > XB_SPIN_CAP) { atomicAdd(&bar[XB_TMO], 1u); break; } }
    }
    nloc = mine > 0u ? mine : 1u; nx = cnt > 0u ? cnt : 1u;
}
__device__ __forceinline__ void grid_bar(unsigned* bar, unsigned x, xb_lds_t st) {
    asm volatile("s_waitcnt vmcnt(0)" ::: "memory");
    __syncthreads();
    if (threadIdx.x == 0) {
        __builtin_amdgcn_s_waitcnt(0);
        unsigned nloc = st[0], nx = st[1];
        if (nloc == 0u) { xcd_barrier_complete(bar, x, nloc, nx); st[0] = nloc; st[1] = nx; }
        const unsigned old = xb_add(&bar[XB_XSUB(x)], 1u);
        const unsigned gen = old / nloc;
        if (old + 1u == (gen + 1u) * nloc) {
            __builtin_amdgcn_fence(__ATOMIC_RELEASE, "agent");
            asm volatile("s_waitcnt vmcnt(0)" ::: "memory");
            const unsigned og = xb_add(&bar[XB_TOP], 1u);
            const unsigned tg = og / nx;
            if (og + 1u == (tg + 1u) * nx) xb_add(&bar[XB_TOPGEN], 1u);
            else XB_SPIN(xb_ld(&bar[XB_TOPGEN]) == tg, bar);
            __builtin_amdgcn_fence(__ATOMIC_ACQUIRE, "agent");
            xb_add(&bar[XB_XGEN(x)], 1u);
            asm volatile("s_waitcnt vmcnt(0)" ::: "memory");
        } else {
            XB_SPIN(xb_ld(&bar[XB_XGEN(x)]) == gen, bar);
            __builtin_amdgcn_fence(__ATOMIC_ACQUIRE, "agent");
            asm volatile("s_waitcnt vmcnt(0)" ::: "memory");
        }
    }
    __syncthreads();
}

constexpr int NPHASE = 2 + 5 * NL;
__global__ void __launch_bounds__(NTHREADS) mega(Params p) {
    extern __shared__ __attribute__((aligned(16))) unsigned char lds[];
    const int bid = blockIdx.x, nblk = gridDim.x;
    unsigned* bar = (unsigned*)(p.ws + W_BAR);
    xb_lds_t st = (xb_lds_t)(lds + LDS_BYTES);
    const unsigned xcc = xb_xcc_id();
    if (threadIdx.x == 0) { st[0] = 0u; st[1] = 0u; (void)xb_add(&bar[XB_XCNT(xcc)], 1u); }
    __syncthreads();
    for (int ph = p.ph_lo; ph < p.ph_hi; ++ph) {
        if (ph > p.ph_lo) {
            if (p.ph_hi < 0) cg::this_grid().sync();
            grid_bar(bar, xcc, st);
        }
        if (ph == 0) { phase0(p, lds, bid, nblk); continue; }
        if (ph == NPHASE - 1) { phaseN(p, NL - 1, bid, nblk); continue; }
        const int l = (ph - 1) / 5, sub = (ph - 1) % 5;
        const int reps = ((DUPMASK >> sub) & 1) ? 2 : 1;
        for (int rep = 0; rep < reps; ++rep) {
            if (rep) grid_bar(bar, xcc, st);
            switch (sub) {
                case 0: phaseA(p, l, lds, bid, nblk); break;
                case 1: phaseB1(p, l, lds, bid, nblk); break;
                case 2: phaseB2(p, l, lds, bid, nblk); break;
                case 3: phaseB3(p, l, lds, bid, nblk); break;
                case 4: phaseC(p, l, lds, bid, nblk); break;
                default: phaseN(p, l, bid, nblk); break;
            }
        }
    }
}

extern "C" void kernel_launch(void* const* d_in, const int* in_sizes, int n_in, void* d_out, int out_size, void* d_ws, size_t ws_size, hipStream_t stream) {
    static int grid = 0;
    if (grid == 0) {
        int dev = 0, cus = 0;
        hipGetDevice(&dev);
        hipDeviceGetAttribute(&cus, hipDeviceAttributeMultiprocessorCount, dev);
        hipFuncSetAttribute((const void*)mega, hipFuncAttributeMaxDynamicSharedMemorySize, LDS_BYTES + 16);
        int per_cu = 0;
        hipOccupancyMaxActiveBlocksPerMultiprocessor(&per_cu, (const void*)mega, NTHREADS, LDS_BYTES + 16);
        if (per_cu < 1) per_cu = 1;
        grid = cus;
        if (ws_size < W_END) fprintf(stderr, "kernel_launch: workspace too small: %zu < %zu\n", ws_size, (size_t)W_END);
        (void)hipGetLastError();
    }
    Params p{};
    const float* const* in = (const float* const*)d_in;
    p.x_prompt = in[0]; p.x_sample = in[1]; p.mem_prompt = in[2]; p.state_pool = in[3]; p.state_shift = in[4]; p.state_wkv = in[5]; p.cache_k = in[6]; p.cache_v = in[7];
    p.norm_g = in[8]; p.w_in = in[9]; p.w_out = in[10]; p.pool_w = in[11]; p.pool_scale = in[12]; p.shift_mu = in[13]; p.w0 = in[14]; p.w_w2 = in[15]; p.a0 = in[16]; p.w_a2 = in[17];
    p.k_k = in[18]; p.k_a = in[19]; p.r_k = in[20]; p.ln_g = in[21]; p.ln_b = in[22]; p.mem_norm_g = in[23]; p.w_kv = in[24]; p.final_g = in[25];
    p.out = (float*)d_out; p.ws = (unsigned char*)d_ws;
#if MULTI_LAUNCH
    for (int ph = 0; ph < NPHASE; ++ph) {
        p.ph_lo = ph; p.ph_hi = ph + 1;
        hipLaunchKernelGGL(mega, dim3(grid), dim3(NTHREADS), LDS_BYTES + 16, stream, p);
    }
#else
    p.ph_lo = 0; p.ph_hi = NPHASE;
    (void)hipMemsetAsync((unsigned char*)d_ws + W_BAR, 0, 16384, stream);
    void* args[] = {&p};
    hipError_t e = hipLaunchCooperativeKernel((const void*)mega, dim3(grid), dim3(NTHREADS), args, LDS_BYTES + 16, stream);
    if (e != hipSuccess) fprintf(stderr, "cooperative launch failed: %s (grid %d)\n", hipGetErrorString(e), grid);
#endif
}
```
